# Optimizing an MI355X kernel written in HIP

```python
import jax
import jax.numpy as jnp
from jax import lax
import numpy as np


D_MODEL = 1024
BATCH = 8
SEQ = 2048
DEPTH = 1
DEC_BATCH = 128
DEC_SEQ = 4
PAST_LEN = 2048
PAGE_SIZE = 128

HEAD_DIM = 64
HEADS_PER_GROUP = 4
DIL_GROUPS = ((128, 1), (512, 4), (2048, 16))
N_DGROUPS = len(DIL_GROUPS)
ATTN_WIDTH = N_DGROUPS * HEADS_PER_GROUP * HEAD_DIM
COMB_WIDTH = HEADS_PER_GROUP * HEAD_DIM
BLOCK = 128
CHUNK = 128
SG_GROUPS = 4
SG_WIDTH = 512
SG_GROUP_DIM = SG_WIDTH // SG_GROUPS
D_FF = 4 * D_MODEL
IN_WIDTH = 3 * ATTN_WIDTH + 2 * SG_WIDTH + 2 * D_MODEL
EPS = 1e-6
NEG = -1e30
SCALE = HEAD_DIM ** -0.5

kernel_name = 'hybrid_dilated_attn_gmlp_step'


def rms_norm(x, g):
    xf = x.astype(jnp.float32)
    y = xf * lax.rsqrt(jnp.mean(xf * xf, axis=-1, keepdims=True) + EPS)
    return (y * g.astype(jnp.float32)).astype(x.dtype)


def layer_norm(x, g, b):
    xf = x.astype(jnp.float32)
    mu = jnp.mean(xf, axis=-1, keepdims=True)
    var = jnp.mean(jnp.square(xf - mu), axis=-1, keepdims=True)
    y = (xf - mu) * lax.rsqrt(var + EPS)
    return (y * g.astype(jnp.float32) + b.astype(jnp.float32)).astype(x.dtype)


def project_inputs(h, w_in, b_gate):
    p = h @ w_in
    a = ATTN_WIDTH
    zs = 3 * a
    gs = zs + 2 * SG_WIDTH
    heads = h.shape[:-1] + (N_DGROUPS, HEADS_PER_GROUP, HEAD_DIM)
    q = p[..., :a].reshape(heads)
    k = p[..., a:2 * a].reshape(heads)
    v = p[..., 2 * a:zs].reshape(heads)
    z = jax.nn.gelu(p[..., zs:gs], approximate=False)
    gates = jax.nn.sigmoid((p[..., gs:] + b_gate).astype(jnp.float32)).astype(h.dtype)
    return q, k, v, z[..., :SG_WIDTH], z[..., SG_WIDTH:], gates[..., :D_MODEL], gates[..., D_MODEL:]


def banded_attention(q, k, v, reach):
    n, L, H, hd = q.shape
    nb = -(-L // BLOCK)
    lp = nb * BLOCK
    qb = jnp.pad(q, ((0, 0), (0, lp - L), (0, 0), (0, 0))).reshape(n, nb, BLOCK, H, hd)

    def key_blocks(t):
        tp = jnp.pad(t, ((0, 0), (BLOCK, lp - L), (0, 0), (0, 0))).reshape(n, nb + 1, BLOCK, H, hd)
        return jnp.concatenate([tp[:, :-1], tp[:, 1:]], axis=2)

    kb, vb = key_blocks(k), key_blocks(v)
    s = jnp.einsum('nbqhd,nbkhd->nbhqk', qb, kb).astype(jnp.float32) * SCALE
    qi = jnp.arange(BLOCK)[:, None]
    ki = jnp.arange(2 * BLOCK)[None, :]
    dist = qi + BLOCK - ki
    kpos = (jnp.arange(nb)[:, None, None] - 1) * BLOCK + ki[None]
    mask = (dist >= 0) & (dist <= reach) & (kpos >= 0)
    s = jnp.where(mask[None, :, None], s, NEG)
    lse = jax.nn.logsumexp(s, axis=-1)
    p = jnp.exp(s - lse[..., None]).astype(v.dtype)
    o = jnp.einsum('nbhqk,nbkhd->nbqhd', p, vb).reshape(n, lp, H, hd)[:, :L]
    lse = lse.transpose(0, 1, 3, 2).reshape(n, lp, H)[:, :L]
    return o, lse


def dilated_group_prompt(q, k, v, window, dil):
    b, s, H, hd = q.shape
    L = s // dil

    def to_res(t):
        return t.reshape(b, L, dil, H, hd).transpose(0, 2, 1, 3, 4).reshape(b * dil, L, H, hd)

    o, lse = banded_attention(to_res(q), to_res(k), to_res(v), window // dil)
    o = o.reshape(b, dil, L, H, hd).transpose(0, 2, 1, 3, 4).reshape(b, s, H, hd)
    lse = lse.reshape(b, dil, L, H).transpose(0, 2, 1, 3).reshape(b, s, H)
    return o, lse


def dilated_group_sample(q, k, v, buf, window, dil):
    t = q.shape[1]
    wb = buf.shape[1]
    kc = jnp.concatenate([buf[:, :, 0], k], axis=1)
    vc = jnp.concatenate([buf[:, :, 1], v], axis=1)
    n_keys = window // dil + 1
    idx = wb + jnp.arange(t)[:, None] - dil * jnp.arange(n_keys)[None, :]
    valid = idx >= 0
    idx = jnp.maximum(idx, 0)
    kg = kc[:, idx]
    vg = vc[:, idx]
    s = jnp.einsum('bthd,btjhd->bhtj', q, kg).astype(jnp.float32) * SCALE
    s = jnp.where(valid[None, None], s, NEG)
    lse = jax.nn.logsumexp(s, axis=-1)
    p = jnp.exp(s - lse[..., None]).astype(v.dtype)
    o = jnp.einsum('bhtj,btjhd->bthd', p, vg)
    return o, lse.transpose(0, 2, 1)


def merge_dilations(outs, lses):
    alpha = jax.nn.softmax(jnp.stack(lses, 0), axis=0).astype(outs[0].dtype)
    o = jnp.einsum('gbsh,gbshd->bshd', alpha, jnp.stack(outs, 0))
    return o.reshape(o.shape[:2] + (COMB_WIDTH,))


def spatial_gate_prompt(z1, z2, ln_z_g, ln_z_b, w_spatial, b_spatial):
    b, s, _ = z1.shape
    zn = layer_norm(z2, ln_z_g, ln_z_b).reshape(b, s // CHUNK, CHUNK, SG_GROUPS, SG_GROUP_DIM)
    mix = jnp.einsum('gts,bcsgk->bctgk', jnp.tril(w_spatial), zn) + b_spatial.T[:, :, None]
    return z1 * mix.reshape(b, s, SG_WIDTH)


def spatial_gate_sample(z1, z2, ln_z_g, ln_z_b, w_spatial, b_spatial):
    b, t, _ = z1.shape
    zn = layer_norm(z2, ln_z_g, ln_z_b)
    zg = zn.reshape(b, t, SG_GROUPS, SG_GROUP_DIM)
    mix = jnp.einsum('gts,bsgk->btgk', jnp.tril(w_spatial)[:, :t, :t], zg) + b_spatial[:, :t].T[:, :, None]
    return z1 * mix.reshape(b, t, SG_WIDTH), zn


def run_layer(x, bufs, norm_pre_mix, w_in, b_gate, ln_z_g, ln_z_b, w_spatial, b_spatial,
              w_ao, w_bo, w_out, norm_post_mix, norm_pre_ffn, w_up, w_down, norm_post_ffn):
    h = rms_norm(x, norm_pre_mix)
    q, k, v, z1, z2, g_a, g_b = project_inputs(h, w_in, b_gate)
    outs, lses, kv_new = [], [], []
    for gi, (win, dil) in enumerate(DIL_GROUPS):
        qg, kg, vg = q[:, :, gi], k[:, :, gi], v[:, :, gi]
        if bufs is None:
            o, lse = dilated_group_prompt(qg, kg, vg, win, dil)
            keep = min(win, x.shape[1])
            kv_new.append(jnp.stack([kg[:, -keep:], vg[:, -keep:]], axis=2))
        else:
            o, lse = dilated_group_sample(qg, kg, vg, bufs[gi], win, dil)
            kv_new.append(jnp.stack([kg, vg], axis=2))
        outs.append(o)
        lses.append(lse)
    o_a = merge_dilations(outs, lses)
    if bufs is None:
        o_b = spatial_gate_prompt(z1, z2, ln_z_g, ln_z_b, w_spatial, b_spatial)
        sg_new = None
    else:
        o_b, sg_new = spatial_gate_sample(z1, z2, ln_z_g, ln_z_b, w_spatial, b_spatial)
    merged = g_a * (o_a @ w_ao) + g_b * (o_b @ w_bo)
    x = x + rms_norm(merged @ w_out, norm_post_mix)
    h2 = rms_norm(x, norm_pre_ffn)
    f = jnp.square(jax.nn.relu(h2 @ w_up)) @ w_down
    x = x + rms_norm(f, norm_post_ffn)
    return x, kv_new, sg_new


def setup_inputs(seed: int = 0) -> dict:
    key = jax.random.key(seed)
    ks = jax.random.split(key, 24)
    f32 = jnp.float32

    def nrm(k, shape, scale):
        return jax.random.normal(k, shape, f32) * scale

    def gain(k, n):
        return 1.0 + 0.05 * jax.random.normal(k, (DEPTH, n), f32)

    def cache(k, win):
        return nrm(k, (DEPTH, DEC_BATCH, min(win, PAST_LEN), 2, HEADS_PER_GROUP, HEAD_DIM), 1.0)

    return {
        'x_prompt': nrm(ks[0], (BATCH, SEQ, D_MODEL), 1.0),
        'x_sample': nrm(ks[1], (DEC_BATCH, DEC_SEQ, D_MODEL), 1.0),
        'cache_kv_w128': cache(ks[2], DIL_GROUPS[0][0]),
        'cache_kv_w512': cache(ks[3], DIL_GROUPS[1][0]),
        'cache_kv_w2048': cache(ks[4], DIL_GROUPS[2][0]),
        'norm_pre_mix': gain(ks[5], D_MODEL),
        'w_in': nrm(ks[6], (DEPTH, D_MODEL, IN_WIDTH), D_MODEL ** -0.5),
        'b_gate': nrm(ks[7], (DEPTH, 2 * D_MODEL), 0.02),
        'ln_z_g': gain(ks[8], SG_WIDTH),
        'ln_z_b': nrm(ks[9], (DEPTH, SG_WIDTH), 0.02),
        'w_spatial': nrm(ks[10], (DEPTH, SG_GROUPS, CHUNK, CHUNK), CHUNK ** -0.5),
        'b_spatial': 1.0 + nrm(ks[11], (DEPTH, SG_GROUPS, CHUNK), 0.1),
        'w_ao': nrm(ks[12], (DEPTH, COMB_WIDTH, D_MODEL), COMB_WIDTH ** -0.5),
        'w_bo': nrm(ks[13], (DEPTH, SG_WIDTH, D_MODEL), SG_WIDTH ** -0.5),
        'w_out': nrm(ks[14], (DEPTH, D_MODEL, D_MODEL), D_MODEL ** -0.5),
        'norm_post_mix': gain(ks[15], D_MODEL),
        'norm_pre_ffn': gain(ks[16], D_MODEL),
        'w_up': nrm(ks[17], (DEPTH, D_MODEL, D_FF), D_MODEL ** -0.5),
        'w_down': nrm(ks[18], (DEPTH, D_FF, D_MODEL), D_FF ** -0.5),
        'norm_post_ffn': gain(ks[19], D_MODEL),
    }


def reference(x_prompt, x_sample, cache_kv_w128, cache_kv_w512, cache_kv_w2048,
              norm_pre_mix, w_in, b_gate, ln_z_g, ln_z_b, w_spatial, b_spatial,
              w_ao, w_bo, w_out, norm_post_mix, norm_pre_ffn, w_up, w_down, norm_post_ffn):
    y_p, y_s = x_prompt, x_sample
    kv_p = [[] for _ in DIL_GROUPS]
    kv_s = [[] for _ in DIL_GROUPS]
    sg_s = []
    for l in range(DEPTH):
        weights = (norm_pre_mix[l], w_in[l], b_gate[l], ln_z_g[l], ln_z_b[l], w_spatial[l],
                   b_spatial[l], w_ao[l], w_bo[l], w_out[l], norm_post_mix[l], norm_pre_ffn[l],
                   w_up[l], w_down[l], norm_post_ffn[l])
        y_p, kvp, _ = run_layer(y_p, None, *weights)
        bufs = (cache_kv_w128[l], cache_kv_w512[l], cache_kv_w2048[l])
        y_s, kvs, sgn = run_layer(y_s, bufs, *weights)
        for gi in range(N_DGROUPS):
            kv_p[gi].append(kvp[gi])
            kv_s[gi].append(kvs[gi])
        sg_s.append(sgn)
    return (y_p, y_s,
            jnp.stack(kv_p[0]), jnp.stack(kv_p[1]), jnp.stack(kv_p[2]),
            jnp.stack(kv_s[0]), jnp.stack(kv_s[1]), jnp.stack(kv_s[2]),
            jnp.stack(sg_s))
```

```cpp
#include <hip/hip_runtime.h>
#include <hip/hip_cooperative_groups.h>
#include <cstdio>
#include <cstdint>
namespace cg = cooperative_groups;
namespace pg8 {
#define PG8_LAS __attribute__((address_space(3)))
typedef unsigned short bf16_t;
typedef short bf16x8 __attribute__((ext_vector_type(8)));
typedef float f32x4 __attribute__((ext_vector_type(4)));
typedef unsigned u32x4 __attribute__((ext_vector_type(4)));
constexpr int BM = 256, BK = 64, HALF = 128, HTB = HALF * BK * 2  , STAGE_BYTES = 8 * HTB, NXCD = 8, WGM = 8;

__host__ __device__ __forceinline__ int lds_byte(int r, int c) { const int st = (r >> 4) * 2 + (c >> 5), rr = r & 15, cc = c & 31, ob = rr * 64 + cc * 2; return st * 1024 + (ob ^ (((ob >> 9) & 1) << 5)); }
__host__ __device__ __forceinline__ void stage_rc(int b, int& R, int& C) { const int st = b / 1024, sb = b % 1024, swz = sb ^ (((sb >> 9) & 1) << 5); R = (st >> 1) * 16 + swz / 64; C = (st & 1) * 32 + (swz % 64) / 2; }
__host__ __device__ __forceinline__ int perm32(int rho) { const int n = rho >> 4, i = rho & 15; return 8 * (i >> 2) + 4 * n + (i & 3); }

struct Unit { int pm, pn; };
struct Gemm { const bf16_t* A; const bf16_t* Bt; int M, N, K; };

struct StaticOrder {
    int nM, nN, nwg, G, c;
    __host__ __device__ void init(int M, int N, int G_, int c_) { nM = M / BM; nN = N / BM; nwg = nM * nN; G = G_; c = c_; }
    __host__ __device__ bool next(int i, Unit& u) const {
        const long L = (long)i * G + c; if (L >= nwg) return false;
        int wgid = (int)L; { const int q = nwg / NXCD, r = nwg % NXCD, xcd = wgid % NXCD, off = wgid / NXCD; wgid = (xcd < r ? xcd * (q + 1) : r * (q + 1) + (xcd - r) * q) + off; }
        const int nig = WGM * nN, gid = wgid / nig, fm = gid * WGM, gsz = (nM - fm) < WGM ? (nM - fm) : WGM;
        u.pm = fm + ((wgid % nig) % gsz); u.pn = (wgid % nig) / gsz; return true;
    }
    __device__ __forceinline__ void a_ready(const Unit&) const {}
    __device__ __forceinline__ void done(const Unit&) const {}
};
__device__ __forceinline__ unsigned cvt_pk_bf16(float lo, float hi) { unsigned r; asm volatile("v_cvt_pk_bf16_f32 %0, %1, %2" : "=v"(r) : "v"(lo), "v"(hi)); return r; }
typedef float f32x2 __attribute__((ext_vector_type(2)));
template <class Epi, class Sched, bool ALIGN_EPI = false, bool SP2 = false>
__device__ __forceinline__ void gemm_phase(PG8_LAS unsigned char* lds, const Gemm g, const Sched& S, const Epi& E) {
    int tid_ = threadIdx.x; asm volatile("" : "+v"(tid_));
    const int tid = tid_, wid = __builtin_amdgcn_readfirstlane(tid >> 6), lane = tid & 63, wr = wid >> 2, wc = wid & 3, fr = lane & 15, fq = lane >> 4;
    const int K = g.K, nt = K / BK;
    unsigned voffA[2], voffB[2];
#pragma unroll
    for (int i = 0; i < 2; ++i) { int R, C; stage_rc(tid * 16 + i * 8192, R, C); const int Rb = Epi::PERM ? ((R & ~31) + perm32(R & 31)) : R;
        voffA[i] = (unsigned)(R * K + C) * 2u; voffB[i] = (unsigned)(Rb * K + C) * 2u; }
    const size_t kstep = (size_t)(BK * 2);
    const size_t hstep = (size_t)HALF * K * 2;
    const size_t tstep = 2 * hstep;
    const unsigned ldsw = (unsigned)wid * 1024u;
    const int aoff = lds_byte(wr * 64 + fr, fq * 8), boff = lds_byte(wc * 32 + fr, fq * 8);
#define PG8_SA(b, h) (((b) * 2 + (h)) * HTB)
#define PG8_SB(b, h) ((4 + (b) * 2 + (h)) * HTB)
#define PG8_STAGE(bufoff, gbase, voff) do { _Pragma("unroll") for (int _i = 0; _i < 2; ++_i) \
        __builtin_amdgcn_global_load_lds((const unsigned*)((const char*)(gbase) + (voff)[_i]), (PG8_LAS unsigned*)(lds + (bufoff) + ldsw + _i * 8192), 16, 0, 0); } while (0)
#define PG8_LDA(dst, b, h) do { _Pragma("unroll") for (int m = 0; m < 4; ++m) _Pragma("unroll") for (int k = 0; k < 2; ++k) dst[m][k] = *(const PG8_LAS bf16x8*)(lds + PG8_SA(b, h) + aoff + m * 2048 + k * 1024); } while (0)
#define PG8_LDB(dst, b, h) do { _Pragma("unroll") for (int n = 0; n < 2; ++n) _Pragma("unroll") for (int k = 0; k < 2; ++k) dst[n][k] = *(const PG8_LAS bf16x8*)(lds + PG8_SB(b, h) + boff + n * 2048 + k * 1024); } while (0)
#define PG8_MMA(ai, bj, At, Bt) do { __builtin_amdgcn_s_setprio(1); _Pragma("unroll") for (int m = 0; m < 4; ++m) _Pragma("unroll") for (int n = 0; n < 2; ++n) _Pragma("unroll") for (int k = 0; k < 2; ++k) \
        acc[ai][bj][m][n] = __builtin_amdgcn_mfma_f32_16x16x32_bf16(Bt[n][k], At[m][k], acc[ai][bj][m][n], 0, 0, 0); __builtin_amdgcn_s_setprio(0); } while (0)
#define PG8_WAIT_V(n) asm volatile("s_waitcnt vmcnt(" #n ")" ::: "memory")
#define PG8_WAIT_L(n) asm volatile("s_waitcnt lgkmcnt(" #n ")" ::: "memory")
#define PG8_BAR __builtin_amdgcn_s_barrier()
#define PG8_SCHED __builtin_amdgcn_sched_barrier(0)
    Unit cur, nxt; int ui = 0;
    if (!S.next(0, cur)) return;
    f32x4 acc[2][2][4][2];
#pragma unroll
    for (int a = 0; a < 2; ++a)
#pragma unroll
        for (int b = 0; b < 2; ++b)
#pragma unroll
            for (int m = 0; m < 4; ++m)
#pragma unroll
                for (int n = 0; n < 2; ++n) acc[a][b][m][n] = (f32x4){0.f, 0.f, 0.f, 0.f};
    bf16x8 At[4][2], B0[2][2], B1[2][2];
    const char* cA = (const char*)g.A + (size_t)cur.pm * tstep; const char* cB = (const char*)g.Bt + (size_t)cur.pn * tstep;
    S.a_ready(cur);
    if constexpr (SP2) {
        PG8_STAGE(PG8_SB(0, 0), cB, voffB); PG8_STAGE(PG8_SB(0, 1), cB + hstep, voffB); PG8_STAGE(PG8_SA(0, 0), cA, voffA); PG8_STAGE(PG8_SA(0, 1), cA + hstep, voffA);
        if (wr == 1) PG8_BAR;
        PG8_WAIT_V(2); PG8_BAR;
        PG8_STAGE(PG8_SB(1, 0), cB + kstep, voffB); PG8_STAGE(PG8_SA(1, 0), cA + kstep, voffA); PG8_STAGE(PG8_SB(1, 1), cB + hstep + kstep, voffB);
        PG8_WAIT_V(6); PG8_BAR;
    } else {
        PG8_STAGE(PG8_SB(0, 0), cB, voffB); PG8_STAGE(PG8_SA(0, 0), cA, voffA); PG8_STAGE(PG8_SB(0, 1), cB + hstep, voffB); PG8_STAGE(PG8_SA(0, 1), cA + hstep, voffA);
        if (wr == 1) PG8_BAR;
        PG8_WAIT_V(4); PG8_BAR;
        PG8_STAGE(PG8_SB(1, 0), cB + kstep, voffB); PG8_STAGE(PG8_SA(1, 0), cA + kstep, voffA); PG8_STAGE(PG8_SB(1, 1), cB + hstep + kstep, voffB);
        PG8_WAIT_V(6); PG8_BAR;
    }
    for (;;) {
        const bool has_next = S.next(ui + 1, nxt);
        const char* nA = has_next ? (const char*)g.A + (size_t)nxt.pm * tstep : cA; const char* nB = has_next ? (const char*)g.Bt + (size_t)nxt.pn * tstep : cB;
        for (int t = 0; t < nt; t += 2) {
            const bool last = (t == nt - 2);
            const char* a1 = cA + (size_t)(t + 1) * kstep;
            const char* a2 = last ? nA : cA + (size_t)(t + 2) * kstep; const char* b2 = last ? nB : cB + (size_t)(t + 2) * kstep;
            const char* a3 = a2 + kstep; const char* b3 = b2 + kstep;
            if (last && has_next) S.a_ready(nxt);
            if constexpr (SP2) {
            PG8_LDB(B0, 0, 0); PG8_LDB(B1, 0, 1); PG8_SCHED; PG8_LDA(At, 0, 0); PG8_STAGE(PG8_SA(1, 1), a1 + hstep, voffA);
            PG8_WAIT_V(8); PG8_WAIT_L(0); PG8_BAR; PG8_MMA(0, 0, At, B0); PG8_MMA(0, 1, At, B1); PG8_BAR; PG8_SCHED;
            PG8_LDA(At, 0, 1); PG8_STAGE(PG8_SB(0, 0), b2, voffB); PG8_STAGE(PG8_SB(0, 1), b2 + hstep, voffB); PG8_STAGE(PG8_SA(0, 0), a2, voffA);
            PG8_WAIT_V(8); PG8_WAIT_L(0); PG8_BAR; PG8_MMA(1, 0, At, B0); PG8_MMA(1, 1, At, B1); PG8_BAR; PG8_SCHED;
            PG8_LDB(B0, 1, 0); PG8_LDB(B1, 1, 1); PG8_SCHED; PG8_LDA(At, 1, 0); PG8_STAGE(PG8_SA(0, 1), a2 + hstep, voffA);
            PG8_WAIT_V(8); PG8_WAIT_L(0); PG8_BAR; PG8_MMA(0, 0, At, B0); PG8_MMA(0, 1, At, B1); PG8_BAR; PG8_SCHED;
            PG8_LDA(At, 1, 1); PG8_STAGE(PG8_SB(1, 0), b3, voffB); PG8_STAGE(PG8_SB(1, 1), b3 + hstep, voffB); PG8_STAGE(PG8_SA(1, 0), a3, voffA);
            PG8_WAIT_V(8); PG8_WAIT_L(0); PG8_BAR; PG8_MMA(1, 0, At, B0); PG8_MMA(1, 1, At, B1); PG8_BAR; PG8_SCHED;
            } else {
            PG8_LDB(B0, 0, 0); PG8_SCHED; PG8_LDA(At, 0, 0); PG8_STAGE(PG8_SA(1, 1), a1 + hstep, voffA);
            PG8_WAIT_L(8); PG8_BAR; PG8_WAIT_L(0); PG8_MMA(0, 0, At, B0); PG8_BAR; PG8_SCHED;
            PG8_LDB(B1, 0, 1); PG8_STAGE(PG8_SB(0, 0), b2, voffB);
            PG8_BAR; PG8_WAIT_L(0); PG8_MMA(0, 1, At, B1); PG8_BAR;
            PG8_LDA(At, 0, 1); PG8_STAGE(PG8_SA(0, 0), a2, voffA);
            PG8_BAR; PG8_WAIT_L(0); PG8_MMA(1, 0, At, B0); PG8_BAR; PG8_SCHED;
            PG8_STAGE(PG8_SB(0, 1), b2 + hstep, voffB);
            PG8_WAIT_V(6); PG8_BAR; PG8_MMA(1, 1, At, B1); PG8_BAR;
            PG8_LDB(B0, 1, 0); PG8_SCHED; PG8_LDA(At, 1, 0); PG8_STAGE(PG8_SA(0, 1), a2 + hstep, voffA);
            PG8_WAIT_L(8); PG8_BAR; PG8_WAIT_L(0); PG8_MMA(0, 0, At, B0); PG8_BAR; PG8_SCHED;
            PG8_LDB(B1, 1, 1); PG8_STAGE(PG8_SB(1, 0), b3, voffB);
            PG8_BAR; PG8_WAIT_L(0); PG8_MMA(0, 1, At, B1); PG8_BAR;
            PG8_LDA(At, 1, 1); PG8_STAGE(PG8_SA(1, 0), a3, voffA);
            PG8_BAR; PG8_WAIT_L(0); PG8_MMA(1, 0, At, B0); PG8_BAR; PG8_SCHED;
            PG8_STAGE(PG8_SB(1, 1), b3 + hstep, voffB);
            PG8_WAIT_V(6); PG8_BAR; PG8_MMA(1, 1, At, B1); PG8_BAR;
            }
        }
        if constexpr (ALIGN_EPI) { if (wr == 0) PG8_BAR; }
        if constexpr (!Epi::AFTER_DRAIN) { E(acc, cur, wr, wc, fr, fq); S.done(cur); }
        if (!has_next) break;
#pragma unroll
        for (int a = 0; a < 2; ++a)
#pragma unroll
            for (int b = 0; b < 2; ++b)
#pragma unroll
                for (int m = 0; m < 4; ++m)
#pragma unroll
                    for (int n = 0; n < 2; ++n) acc[a][b][m][n] = (f32x4){0.f, 0.f, 0.f, 0.f};
        cur = nxt; cA = nA; cB = nB; ++ui;
        if constexpr (ALIGN_EPI) { if (wr == 1) PG8_BAR; }
    }
    PG8_WAIT_V(0);
    if constexpr (!ALIGN_EPI) { if (wr == 0) PG8_BAR; }
    PG8_BAR;
    if constexpr (Epi::AFTER_DRAIN) { E.fused(acc, cur, wr, wc, fr, fq, lds, wid, lane); S.done(cur); }
#undef PG8_SA
#undef PG8_SB
#undef PG8_STAGE
#undef PG8_LDA
#undef PG8_LDB
#undef PG8_MMA
#undef PG8_WAIT_V
#undef PG8_WAIT_L
#undef PG8_BAR
#undef PG8_SCHED
}
}

using pg8::bf16_t; using pg8::bf16x8; using pg8::f32x4; using pg8::u32x4; using pg8::Unit; using pg8::cvt_pk_bf16;
#define LAS __attribute__((address_space(3)))
typedef unsigned long long u64;
typedef unsigned u32x2 __attribute__((ext_vector_type(2)));

constexpr int MP = 16384, MS = 512, MT = MP + MS;
constexpr int DM = 1024, NIN = 5376, FF = 4096, NQKV = 2304;
constexpr float EPS = 1e-6f, SCALE = 0.125f, LOG2E = 1.4426950408889634f;
constexpr size_t O_Y = 0, O_KVP0 = 17301504, O_KVP1 = 17825792, O_KVP2 = 19922944, O_KVS0 = 28311552, O_KVS1 = 28573696, O_KVS2 = 28835840, O_SG = 29097984;
constexpr size_t al(size_t x) { return (x + 4095) & ~(size_t)4095; }
constexpr size_t WS_RSS   = 0;
constexpr size_t WS_WIN   = al(WS_RSS + 2 * MT * 4);
constexpr size_t WS_WAO   = al(WS_WIN + (size_t)NIN * DM * 2);
constexpr size_t WS_WBO   = al(WS_WAO + (size_t)DM * 256 * 2);
constexpr size_t WS_WOUT  = al(WS_WBO + (size_t)DM * 512 * 2);
constexpr size_t WS_WUP   = al(WS_WOUT + (size_t)DM * DM * 2);
constexpr size_t WS_WDN   = al(WS_WUP + (size_t)FF * DM * 2);
constexpr size_t WS_XN    = al(WS_WDN + (size_t)DM * FF * 2);
constexpr size_t WS_QKV   = al(WS_XN + (size_t)MT * DM * 2);
constexpr size_t WS_VT    = al(WS_QKV + (size_t)MT * NQKV * 2);
constexpr size_t WS_Z     = al(WS_VT + (size_t)8 * 3 * 4 * 64 * 2048 * 2);
constexpr size_t WS_G     = al(WS_Z + (size_t)MT * 1024 * 2);
constexpr size_t WS_OA    = al(WS_G + (size_t)MT * 2048 * 2);
constexpr size_t WS_OB    = al(WS_OA + (size_t)MT * 256 * 2);
constexpr size_t WS_T     = al(WS_OB + (size_t)MT * 512 * 2);
constexpr size_t WS_MG    = al(WS_T + (size_t)MT * DM * 4);
constexpr size_t WS_U     = al(WS_MG + (size_t)MT * DM * 2);
constexpr size_t WS_END   = al(WS_U + (size_t)MT * FF * 2);
constexpr int LDS_BYTES = 147456;

__device__ __forceinline__ float bf2f(unsigned short h) { return __builtin_bit_cast(float, (unsigned)h << 16); }
__device__ __forceinline__ float bflo(unsigned w) { return __builtin_bit_cast(float, w << 16); }
__device__ __forceinline__ float bfhi(unsigned w) { return __builtin_bit_cast(float, w & 0xffff0000u); }
__device__ __forceinline__ unsigned f2bf(float f) { unsigned u = __builtin_bit_cast(unsigned, f); return (u + 0x7fffu + ((u >> 16) & 1u)) >> 16; }
__device__ __forceinline__ unsigned pk2(float lo, float hi) { return f2bf(lo) | (f2bf(hi) << 16); }
__device__ __forceinline__ float wave_sum(float v) {
#pragma unroll
    for (int o = 1; o < 64; o <<= 1) v += __shfl_xor(v, o);
    return v;
}
__device__ __forceinline__ f32x4 mfma16(bf16x8 a, bf16x8 b, f32x4 c) { return __builtin_amdgcn_mfma_f32_16x16x32_bf16(a, b, c, 0, 0, 0); }

#define EPI_LOOP for (int ai = 0; ai < 2; ++ai) _Pragma("unroll") for (int m = 0; m < 4; ++m) _Pragma("unroll") for (int bj = 0; bj < 2; ++bj)

struct EpiIn {
    static constexpr bool PERM = true, AFTER_DRAIN = false;
    bf16_t* QKV; bf16_t* VT; bf16_t* Z; bf16_t* G; float* out; const float* bgate;
    __device__ __forceinline__ void operator()(const f32x4 (&acc)[2][2][4][2], const Unit& u, int wr, int wc, int fr, int fq) const {
        const int pn = u.pn, row0 = u.pm * 256 + wr * 64 + fr, cl0 = wc * 32 + 8 * fq;
        if (pn < 9) {
            const int g = pn % 3, kvsel = (pn >= 6) ? 1 : 0, sh = 2 * g;
#pragma unroll
            EPI_LOOP {
                const int row = row0 + ai * 128 + m * 16, cl = cl0 + bj * 128;
                const f32x4 v0 = acc[ai][bj][m][0], v1 = acc[ai][bj][m][1];
                u32x4 w; w.x = cvt_pk_bf16(v0[0], v0[1]); w.y = cvt_pk_bf16(v0[2], v0[3]); w.z = cvt_pk_bf16(v1[0], v1[1]); w.w = cvt_pk_bf16(v1[2], v1[3]);
                *(u32x4*)(QKV + (size_t)row * NQKV + pn * 256 + cl) = w;
                if (pn >= 3) {
                    float* dst = nullptr;
                    if (row < MP) {
                        const int b = row >> 11, s = row & 2047;
                        if (g == 0) { if (s >= 1920) dst = out + O_KVP0 + ((size_t)(b * 128 + s - 1920) * 2 + kvsel) * 256; }
                        else if (g == 1) { if (s >= 1536) dst = out + O_KVP1 + ((size_t)(b * 512 + s - 1536) * 2 + kvsel) * 256; }
                        else dst = out + O_KVP2 + ((size_t)(b * 2048 + s) * 2 + kvsel) * 256;
                        if (pn >= 6) {
                            const int r = s & ((1 << sh) - 1), mm = s >> sh, L = 2048 >> sh;
                            bf16_t* vt = VT + ((size_t)((b * 3 + g) * 256 + cl)) * 2048 + r * L + mm;
                            vt[0 * 2048] = (bf16_t)(w.x & 0xffff); vt[1 * 2048] = (bf16_t)(w.x >> 16); vt[2 * 2048] = (bf16_t)(w.y & 0xffff); vt[3 * 2048] = (bf16_t)(w.y >> 16);
                            vt[4 * 2048] = (bf16_t)(w.z & 0xffff); vt[5 * 2048] = (bf16_t)(w.z >> 16); vt[6 * 2048] = (bf16_t)(w.w & 0xffff); vt[7 * 2048] = (bf16_t)(w.w >> 16);
                        }
                    } else {
                        const int rs = row - MP;
                        dst = out + (g == 0 ? O_KVS0 : (g == 1 ? O_KVS1 : O_KVS2)) + ((size_t)rs * 2 + kvsel) * 256;
                    }
                    if (dst) { *(f32x4*)(dst + cl) = v0; *(f32x4*)(dst + cl + 4) = v1; }
                }
            }
        } else if (pn < 13) {
#pragma unroll
            EPI_LOOP {
                const int row = row0 + ai * 128 + m * 16, cl = cl0 + bj * 128;
                f32x4 v0 = acc[ai][bj][m][0], v1 = acc[ai][bj][m][1];
#pragma unroll
                for (int e = 0; e < 4; ++e) { v0[e] = 0.5f * v0[e] * (1.f + erff(v0[e] * 0.70710678118654752f)); v1[e] = 0.5f * v1[e] * (1.f + erff(v1[e] * 0.70710678118654752f)); }
                u32x4 w; w.x = cvt_pk_bf16(v0[0], v0[1]); w.y = cvt_pk_bf16(v0[2], v0[3]); w.z = cvt_pk_bf16(v1[0], v1[1]); w.w = cvt_pk_bf16(v1[2], v1[3]);
                *(u32x4*)(Z + (size_t)row * 1024 + (pn - 9) * 256 + cl) = w;
            }
        } else {
#pragma unroll
            EPI_LOOP {
                const int row = row0 + ai * 128 + m * 16, cg_ = (pn - 13) * 256 + cl0 + bj * 128;
                const f32x4 b0 = *(const f32x4*)(bgate + cg_), b1 = *(const f32x4*)(bgate + cg_ + 4);
                f32x4 v0 = acc[ai][bj][m][0] + b0, v1 = acc[ai][bj][m][1] + b1;
#pragma unroll
                for (int e = 0; e < 4; ++e) { v0[e] = 1.f / (1.f + __expf(-v0[e])); v1[e] = 1.f / (1.f + __expf(-v1[e])); }
                u32x4 w; w.x = cvt_pk_bf16(v0[0], v0[1]); w.y = cvt_pk_bf16(v0[2], v0[3]); w.z = cvt_pk_bf16(v1[0], v1[1]); w.w = cvt_pk_bf16(v1[2], v1[3]);
                *(u32x4*)(G + (size_t)row * 2048 + cg_) = w;
            }
        }
    }
};

struct EpiGateA {
    static constexpr bool PERM = true, AFTER_DRAIN = false;
    const bf16_t* G; float* T;
    __device__ __forceinline__ void operator()(const f32x4 (&acc)[2][2][4][2], const Unit& u, int wr, int wc, int fr, int fq) const {
        const int row0 = u.pm * 256 + wr * 64 + fr, c0 = u.pn * 256 + wc * 32 + 8 * fq;
#pragma unroll
        EPI_LOOP {
            const int row = row0 + ai * 128 + m * 16, col = c0 + bj * 128;
            const u32x4 gw = *(const u32x4*)(G + (size_t)row * 2048 + col);
            f32x4 v0 = acc[ai][bj][m][0], v1 = acc[ai][bj][m][1];
            v0[0] *= bflo(gw.x); v0[1] *= bfhi(gw.x); v0[2] *= bflo(gw.y); v0[3] *= bfhi(gw.y);
            v1[0] *= bflo(gw.z); v1[1] *= bfhi(gw.z); v1[2] *= bflo(gw.w); v1[3] *= bfhi(gw.w);
            float* t = T + (size_t)row * DM + col;
            *(f32x4*)t = v0; *(f32x4*)(t + 4) = v1;
        }
    }
};
struct EpiGateB {
    static constexpr bool PERM = true, AFTER_DRAIN = false;
    const bf16_t* G; const float* T; bf16_t* MG;
    __device__ __forceinline__ void operator()(const f32x4 (&acc)[2][2][4][2], const Unit& u, int wr, int wc, int fr, int fq) const {
        const int row0 = u.pm * 256 + wr * 64 + fr, c0 = u.pn * 256 + wc * 32 + 8 * fq;
#pragma unroll
        EPI_LOOP {
            const int row = row0 + ai * 128 + m * 16, col = c0 + bj * 128;
            const u32x4 gw = *(const u32x4*)(G + (size_t)row * 2048 + 1024 + col);
            const float* t = T + (size_t)row * DM + col;
            f32x4 v0 = *(const f32x4*)t, v1 = *(const f32x4*)(t + 4);
            const f32x4 a0 = acc[ai][bj][m][0], a1 = acc[ai][bj][m][1];
            v0[0] += a0[0] * bflo(gw.x); v0[1] += a0[1] * bfhi(gw.x); v0[2] += a0[2] * bflo(gw.y); v0[3] += a0[3] * bfhi(gw.y);
            v1[0] += a1[0] * bflo(gw.z); v1[1] += a1[1] * bfhi(gw.z); v1[2] += a1[2] * bflo(gw.w); v1[3] += a1[3] * bfhi(gw.w);
            u32x4 w; w.x = cvt_pk_bf16(v0[0], v0[1]); w.y = cvt_pk_bf16(v0[2], v0[3]); w.z = cvt_pk_bf16(v1[0], v1[1]); w.w = cvt_pk_bf16(v1[2], v1[3]);
            *(u32x4*)(MG + (size_t)row * DM + col) = w;
        }
    }
};
struct EpiSS {
    static constexpr bool PERM = true, AFTER_DRAIN = false;
    float* T; float* rss;
    __device__ __forceinline__ void operator()(const f32x4 (&acc)[2][2][4][2], const Unit& u, int wr, int wc, int fr, int fq) const {
        const int row0 = u.pm * 256 + wr * 64 + fr, c0 = u.pn * 256 + wc * 32 + 8 * fq;
#pragma unroll
        for (int ai = 0; ai < 2; ++ai)
#pragma unroll
            for (int m = 0; m < 4; ++m) {
                const int row = row0 + ai * 128 + m * 16; float s = 0.f;
#pragma unroll
                for (int bj = 0; bj < 2; ++bj) {
                    const f32x4 v0 = acc[ai][bj][m][0], v1 = acc[ai][bj][m][1];
                    float* t = T + (size_t)row * DM + c0 + bj * 128;
                    *(f32x4*)t = v0; *(f32x4*)(t + 4) = v1;
                    s += (v0[0] * v0[0] + v0[1] * v0[1]) + (v0[2] * v0[2] + v0[3] * v0[3]) + (v1[0] * v1[0] + v1[1] * v1[1]) + (v1[2] * v1[2] + v1[3] * v1[3]);
                }
                s += __shfl_xor(s, 16); s += __shfl_xor(s, 32);
                if (fq == 0) atomicAdd(rss + row, s);
            }
    }
};
struct EpiUp {
    static constexpr bool PERM = true, AFTER_DRAIN = false;
    bf16_t* U;
    __device__ __forceinline__ void operator()(const f32x4 (&acc)[2][2][4][2], const Unit& u, int wr, int wc, int fr, int fq) const {
        const int row0 = u.pm * 256 + wr * 64 + fr, c0 = u.pn * 256 + wc * 32 + 8 * fq;
#pragma unroll
        EPI_LOOP {
            const int row = row0 + ai * 128 + m * 16, col = c0 + bj * 128;
            f32x4 v0 = acc[ai][bj][m][0], v1 = acc[ai][bj][m][1];
#pragma unroll
            for (int e = 0; e < 4; ++e) { const float a = fmaxf(v0[e], 0.f), b = fmaxf(v1[e], 0.f); v0[e] = a * a; v1[e] = b * b; }
            u32x4 w; w.x = cvt_pk_bf16(v0[0], v0[1]); w.y = cvt_pk_bf16(v0[2], v0[3]); w.z = cvt_pk_bf16(v1[0], v1[1]); w.w = cvt_pk_bf16(v1[2], v1[3]);
            *(u32x4*)(U + (size_t)row * FF + col) = w;
        }
    }
};

__device__ __forceinline__ void p0_transpose_item(const float* W, int K, int N, bf16_t* WT, LAS float* scr, int item, int lane) {
    const int nblk = N / 32, kb = item / nblk, nb = item % nblk, k0 = 64 * kb, n0 = 32 * nb;
#pragma unroll 8
    for (int i = 0; i < 32; ++i) { const int kk = 2 * i + (lane >> 5); scr[kk * 33 + (lane & 31)] = W[(size_t)(k0 + kk) * N + n0 + (lane & 31)]; }
    asm volatile("s_waitcnt lgkmcnt(0)" ::: "memory");
    const int c = lane & 7;
#pragma unroll
    for (int j = 0; j < 4; ++j) { const int n = (lane >> 3) + 8 * j; const LAS float* s = scr + (8 * c) * 33 + n;
        u32x4 o; o.x = pk2(s[0 * 33], s[1 * 33]); o.y = pk2(s[2 * 33], s[3 * 33]); o.z = pk2(s[4 * 33], s[5 * 33]); o.w = pk2(s[6 * 33], s[7 * 33]);
        *(u32x4*)(WT + (size_t)(n0 + n) * K + k0 + 8 * c) = o; }
    asm volatile("s_waitcnt lgkmcnt(0)" ::: "memory");
}

struct KArgs { const float* in[20]; float* out; unsigned char* ws; };

__device__ __forceinline__ const float* xrow_ptr(const KArgs& a, int row) { return row < MP ? a.in[0] + (size_t)row * DM : a.in[1] + (size_t)(row - MP) * DM; }

__device__ __forceinline__ void p0_prologue(const KArgs& a, LAS unsigned char* lds, int wave, int lane, int gw, int NGW) {
    unsigned char* ws = a.ws;
    LAS float* scr = (LAS float*)(lds + wave * 16384);
    constexpr int I0 = (1024 / 64) * (NIN / 32), I1 = (256 / 64) * (1024 / 32), I2 = (512 / 64) * (1024 / 32), I3 = (1024 / 64) * (1024 / 32), I4 = (1024 / 64) * (FF / 32), I5 = (FF / 64) * (1024 / 32);
    constexpr int NIT = I0 + I1 + I2 + I3 + I4 + I5;
    for (int it = gw; it < NIT; it += NGW) {
        int r = it;
        if (r < I0) { p0_transpose_item(a.in[6], 1024, NIN, (bf16_t*)(ws + WS_WIN), scr, r, lane); continue; } r -= I0;
        if (r < I1) { p0_transpose_item(a.in[12], 256, 1024, (bf16_t*)(ws + WS_WAO), scr, r, lane); continue; } r -= I1;
        if (r < I2) { p0_transpose_item(a.in[13], 512, 1024, (bf16_t*)(ws + WS_WBO), scr, r, lane); continue; } r -= I2;
        if (r < I3) { p0_transpose_item(a.in[14], 1024, 1024, (bf16_t*)(ws + WS_WOUT), scr, r, lane); continue; } r -= I3;
        if (r < I4) { p0_transpose_item(a.in[17], 1024, FF, (bf16_t*)(ws + WS_WUP), scr, r, lane); continue; } r -= I4;
        p0_transpose_item(a.in[18], FF, 1024, (bf16_t*)(ws + WS_WDN), scr, r, lane);
    }
    const float* gain = a.in[5];
    bf16_t* XN = (bf16_t*)(ws + WS_XN);
    for (int row = gw; row < MT; row += NGW) {
        const f32x4* xr = (const f32x4*)xrow_ptr(a, row) + lane;
        f32x4 v[4]; float s = 0.f;
#pragma unroll
        for (int j = 0; j < 4; ++j) { v[j] = xr[64 * j]; s += (v[j][0] * v[j][0] + v[j][1] * v[j][1]) + (v[j][2] * v[j][2] + v[j][3] * v[j][3]); }
        const float r = rsqrtf(wave_sum(s) * (1.f / DM) + EPS);
        u32x2* o = (u32x2*)(XN + (size_t)row * DM) + lane;
#pragma unroll
        for (int j = 0; j < 4; ++j) { const f32x4 g = ((const f32x4*)gain)[lane + 64 * j]; u32x2 w; w.x = pk2(v[j][0] * r * g[0], v[j][1] * r * g[1]); w.y = pk2(v[j][2] * r * g[2], v[j][3] * r * g[3]); o[64 * j] = w; }
    }
    float* rss = (float*)(ws + WS_RSS);
    for (int i = gw * 64 + lane; i < 2 * MT; i += NGW * 64) rss[i] = 0.f;
}

constexpr int OST_ROW = 136;
__device__ __forceinline__ void attn_prompt_unit(int u, const bf16_t* QKV, const bf16_t* VT, bf16_t* OA, LAS unsigned char* lds, int wave, int lane) {
    const int b = u >> 5, blk = (u >> 2) & 7, h = u & 3, s0 = blk * 256;
    const int q = lane & 15, c = lane >> 4;
    LAS float* lse_s = (LAS float*)(lds + 3 * 256 * OST_ROW);
    for (int jj = 0; jj < 6; ++jj) {
        const int g = jj >> 1, sub = 2 * wave + (jj & 1), sh = 2 * g, L = 2048 >> sh;
        int r, m0;
        if (g == 0) { r = 0; m0 = s0 + 16 * sub; } else if (g == 1) { r = sub >> 2; m0 = (s0 >> 2) + 16 * (sub & 3); } else { r = sub; m0 = s0 >> 4; }
        const int ktmin = 9 - (m0 >> 4);
        const bf16_t* qrow = QKV + (size_t)(b * 2048 + ((m0 + q) << sh) + r) * NQKV + g * 256 + h * 64 + 8 * c;
        const bf16x8 qf0 = *(const bf16x8*)qrow, qf1 = *(const bf16x8*)(qrow + 32);
        f32x4 st[9];
#pragma unroll
        for (int kt = 1; kt <= 9; ++kt) {
            f32x4 sa = {-1e30f, -1e30f, -1e30f, -1e30f};
            if (kt >= ktmin) {
                const int mk = m0 - 144 + 16 * kt + q;
                const bf16_t* krow = QKV + (size_t)(b * 2048 + (mk << sh) + r) * NQKV + 768 + g * 256 + h * 64 + 8 * c;
                const bf16x8 k0 = *(const bf16x8*)krow, k1 = *(const bf16x8*)(krow + 32);
                f32x4 z = {0.f, 0.f, 0.f, 0.f};
                z = mfma16(k0, qf0, z); z = mfma16(k1, qf1, z);
                if (kt == 1) {
#pragma unroll
                    for (int i = 0; i < 4; ++i) if (4 * c + i < q) z[i] = -1e30f;
                }
                if (kt == 9) {
#pragma unroll
                    for (int i = 0; i < 4; ++i) if (4 * c + i > q) z[i] = -1e30f;
                }
                sa = z;
            }
            st[kt - 1] = sa;
        }
        float mx = -1e30f;
#pragma unroll
        for (int t = 0; t < 9; ++t) mx = fmaxf(mx, fmaxf(fmaxf(st[t][0], st[t][1]), fmaxf(st[t][2], st[t][3])));
        mx = fmaxf(mx, __shfl_xor(mx, 16)); mx = fmaxf(mx, __shfl_xor(mx, 32));
        float ls = 0.f;
#pragma unroll
        for (int t = 0; t < 9; ++t)
#pragma unroll
            for (int i = 0; i < 4; ++i) { const float p = exp2f((st[t][i] - mx) * (SCALE * LOG2E)); st[t][i] = p; ls += p; }
        ls += __shfl_xor(ls, 16); ls += __shfl_xor(ls, 32);
        bf16x8 pf[5];
#pragma unroll
        for (int kb = 0; kb < 5; ++kb) {
            u32x4 w;
            if (kb == 0) { w.x = 0u; w.y = 0u; } else { w.x = cvt_pk_bf16(st[2 * kb - 1][0], st[2 * kb - 1][1]); w.y = cvt_pk_bf16(st[2 * kb - 1][2], st[2 * kb - 1][3]); }
            w.z = cvt_pk_bf16(st[2 * kb][0], st[2 * kb][1]); w.w = cvt_pk_bf16(st[2 * kb][2], st[2 * kb][3]);
            pf[kb] = __builtin_bit_cast(bf16x8, w);
        }
        f32x4 oacc[4];
#pragma unroll
        for (int dt = 0; dt < 4; ++dt) {
            f32x4 o = {0.f, 0.f, 0.f, 0.f};
            const bf16_t* vrow = VT + (size_t)(((b * 3 + g) * 4 + h) * 64 + 16 * dt + q) * 2048 + r * L + 4 * c;
#pragma unroll
            for (int kb = 0; kb < 5; ++kb) {
                if (2 * kb + 1 >= ktmin) {
                    const int mA = m0 - 144 + 32 * kb;
                    u32x2 lo = {0u, 0u}, hi;
                    if (kb > 0 && 2 * kb >= ktmin) lo = *(const u32x2*)(vrow + mA);
                    hi = *(const u32x2*)(vrow + mA + 16);
                    u32x4 w; w.x = lo.x; w.y = lo.y; w.z = hi.x; w.w = hi.y;
                    o = mfma16(__builtin_bit_cast(bf16x8, w), pf[kb], o);
                }
            }
            oacc[dt] = o;
        }
        const float inv = 1.f / ls;
        const int tok = ((m0 + q) << sh) + r - s0;
        LAS unsigned char* orow = lds + (g * 256 + tok) * OST_ROW + 8 * c;
#pragma unroll
        for (int dt = 0; dt < 4; ++dt) {
            u32x2 w; w.x = cvt_pk_bf16(oacc[dt][0] * inv, oacc[dt][1] * inv); w.y = cvt_pk_bf16(oacc[dt][2] * inv, oacc[dt][3] * inv);
            *(LAS u32x2*)(orow + 32 * dt) = w;
        }
        if (c == 0) lse_s[g * 256 + tok] = mx * SCALE + __logf(ls);
    }
    __syncthreads();
    {
        const int tid = wave * 64 + lane, tok = tid >> 1, half = tid & 1;
        const float l0 = lse_s[tok], l1 = lse_s[256 + tok], l2 = lse_s[512 + tok];
        const float mm = fmaxf(l0, fmaxf(l1, l2));
        float e0 = __expf(l0 - mm), e1 = __expf(l1 - mm), e2 = __expf(l2 - mm);
        const float inv = 1.f / (e0 + e1 + e2); e0 *= inv; e1 *= inv; e2 *= inv;
        bf16_t* dst = OA + (size_t)(b * 2048 + s0 + tok) * 256 + h * 64 + half * 32;
#pragma unroll
        for (int ch = 0; ch < 4; ++ch) {
            float o[8];
#pragma unroll
            for (int k2 = 0; k2 < 2; ++k2) {
                const int off = tok * OST_ROW + half * 64 + ch * 16 + k2 * 8;
                const u32x2 a0 = *(const LAS u32x2*)(lds + off), a1 = *(const LAS u32x2*)(lds + 256 * OST_ROW + off), a2 = *(const LAS u32x2*)(lds + 512 * OST_ROW + off);
                o[4 * k2 + 0] = e0 * bflo(a0.x) + e1 * bflo(a1.x) + e2 * bflo(a2.x); o[4 * k2 + 1] = e0 * bfhi(a0.x) + e1 * bfhi(a1.x) + e2 * bfhi(a2.x);
                o[4 * k2 + 2] = e0 * bflo(a0.y) + e1 * bflo(a1.y) + e2 * bflo(a2.y); o[4 * k2 + 3] = e0 * bfhi(a0.y) + e1 * bfhi(a1.y) + e2 * bfhi(a2.y);
            }
            u32x4 w; w.x = cvt_pk_bf16(o[0], o[1]); w.y = cvt_pk_bf16(o[2], o[3]); w.z = cvt_pk_bf16(o[4], o[5]); w.w = cvt_pk_bf16(o[6], o[7]);
            *(u32x4*)(dst + 8 * ch) = w;
        }
    }
    __syncthreads();
}

constexpr int ZT_ROW = 272;
__device__ __forceinline__ void sgate_prompt_unit(int u, const bf16_t* Z, const float* lng, const float* lnb, const float* Wsp, const float* bsp, bf16_t* OB, LAS unsigned char* lds, int wave, int lane) {
    const int chunk = u >> 2, gg = u & 3;
    for (int i = 0; i < 16; ++i) {
        const int tok = wave * 16 + i; const size_t row = (size_t)chunk * 128 + tok;
        const u32x4 raw = *(const u32x4*)(Z + row * 1024 + 512 + 8 * lane);
        float x[8] = {bflo(raw.x), bfhi(raw.x), bflo(raw.y), bfhi(raw.y), bflo(raw.z), bfhi(raw.z), bflo(raw.w), bfhi(raw.w)};
        float s = 0.f;
#pragma unroll
        for (int e = 0; e < 8; ++e) s += x[e];
        const float mean = wave_sum(s) * (1.f / 512.f); float s2 = 0.f;
#pragma unroll
        for (int e = 0; e < 8; ++e) { x[e] -= mean; s2 += x[e] * x[e]; }
        const float rstd = rsqrtf(wave_sum(s2) * (1.f / 512.f) + EPS);
        if ((lane >> 4) == gg) {
            const int fl = 8 * (lane & 15);
#pragma unroll
            for (int e = 0; e < 8; ++e) { const float zn = x[e] * rstd * lng[8 * lane + e] + lnb[8 * lane + e]; *(LAS bf16_t*)(lds + (fl + e) * ZT_ROW + tok * 2) = (bf16_t)f2bf(zn); }
        }
    }
    __syncthreads();
    const int q = lane & 15, c = lane >> 4, t = wave * 16 + q;
    f32x4 acc[8];
#pragma unroll
    for (int kt = 0; kt < 8; ++kt) acc[kt] = (f32x4){0.f, 0.f, 0.f, 0.f};
    const int nks = (wave >> 1) + 1;
    for (int ks = 0; ks < nks; ++ks) {
        const float* wp = Wsp + ((size_t)gg * 128 + t) * 128 + 32 * ks + 8 * c;
        f32x4 w0 = *(const f32x4*)wp, w1 = *(const f32x4*)(wp + 4);
        const int sb = 32 * ks + 8 * c;
#pragma unroll
        for (int e = 0; e < 4; ++e) { if (sb + e > t) w0[e] = 0.f; if (sb + 4 + e > t) w1[e] = 0.f; }
        u32x4 aw; aw.x = cvt_pk_bf16(w0[0], w0[1]); aw.y = cvt_pk_bf16(w0[2], w0[3]); aw.z = cvt_pk_bf16(w1[0], w1[1]); aw.w = cvt_pk_bf16(w1[2], w1[3]);
        const bf16x8 af = __builtin_bit_cast(bf16x8, aw);
#pragma unroll
        for (int kt = 0; kt < 8; ++kt) {
            const bf16x8 bfr = *(const LAS bf16x8*)(lds + (16 * kt + q) * ZT_ROW + sb * 2);
            acc[kt] = mfma16(af, bfr, acc[kt]);
        }
    }
#pragma unroll
    for (int i = 0; i < 4; ++i) {
        const int tt = wave * 16 + 4 * c + i; const size_t row = (size_t)chunk * 128 + tt; const float bb = bsp[gg * 128 + tt];
#pragma unroll
        for (int kt = 0; kt < 8; ++kt) {
            const int col = gg * 128 + 16 * kt + q;
            const float z1 = bf2f(Z[row * 1024 + col]);
            OB[row * 512 + col] = (bf16_t)f2bf(z1 * (acc[kt][i] + bb));
        }
    }
    __syncthreads();
}

__device__ __forceinline__ void attn_sample_item(int it, const KArgs& a, const bf16_t* QKV, bf16_t* OA, LAS unsigned char* lds, int wave, int lane) {
    const int db = it >> 2, t = it & 3;
    LAS float* pm = (LAS float*)lds;
    LAS float* pl = pm + 32;
    LAS float* pacc = pm + 64;
    if (wave < 6) {
        const int g = wave % 3, half = wave / 3, sh = 2 * g, wb = 128 << sh;
        const float* cache = (g == 0 ? a.in[2] : (g == 1 ? a.in[3] : a.in[4])) + (size_t)db * wb * 512;
        const int hh = lane >> 4, dd = 4 * (lane & 15);
        const size_t rowq = (size_t)(MP + db * 4 + t) * NQKV;
        const u32x2 qw = *(const u32x2*)(QKV + rowq + g * 256 + hh * 64 + dd);
        const float q0 = bflo(qw.x), q1 = bfhi(qw.x), q2 = bflo(qw.y), q3 = bfhi(qw.y);
        float m = -1e30f, l = 0.f, a0 = 0.f, a1 = 0.f, a2 = 0.f, a3 = 0.f;
        const int jn = t >> sh;
        int jlo = jn + 1, jhi = 65;
        if (half == 0) {
            for (int j = 0; j <= jn; ++j) {
                const size_t rk = (size_t)(MP + db * 4 + t - (j << sh)) * NQKV + g * 256 + hh * 64 + dd;
                const u32x2 kw = *(const u32x2*)(QKV + rk + 768), vw = *(const u32x2*)(QKV + rk + 1536);
                float d = q0 * bflo(kw.x) + q1 * bfhi(kw.x) + q2 * bflo(kw.y) + q3 * bfhi(kw.y);
                d += __shfl_xor(d, 1); d += __shfl_xor(d, 2); d += __shfl_xor(d, 4); d += __shfl_xor(d, 8);
                const float sc = d * SCALE, mn = fmaxf(m, sc), cr = __expf(m - mn), p = __expf(sc - mn);
                l = l * cr + p; a0 = a0 * cr + p * bflo(vw.x); a1 = a1 * cr + p * bfhi(vw.x); a2 = a2 * cr + p * bflo(vw.y); a3 = a3 * cr + p * bfhi(vw.y); m = mn;
            }
        } else { jlo = 65; jhi = 129; }
        for (int j0 = jlo; j0 < jhi; j0 += 8) {
            f32x4 kk[8], vv[8];
#pragma unroll
            for (int e = 0; e < 8; ++e) {
                const int j = min(j0 + e, jhi - 1);
                const float* p = cache + (size_t)(wb + t - (j << sh)) * 512 + hh * 64 + dd;
                kk[e] = *(const f32x4*)p; vv[e] = *(const f32x4*)(p + 256);
            }
#pragma unroll
            for (int e = 0; e < 8; ++e) {
                float d = q0 * kk[e][0] + q1 * kk[e][1] + q2 * kk[e][2] + q3 * kk[e][3];
                d += __shfl_xor(d, 1); d += __shfl_xor(d, 2); d += __shfl_xor(d, 4); d += __shfl_xor(d, 8);
                const float sc = (j0 + e < jhi) ? d * SCALE : -1e30f;
                const float mn = fmaxf(m, sc), cr = __expf(m - mn), p = __expf(sc - mn);
                l = l * cr + p; a0 = a0 * cr + p * vv[e][0]; a1 = a1 * cr + p * vv[e][1]; a2 = a2 * cr + p * vv[e][2]; a3 = a3 * cr + p * vv[e][3]; m = mn;
            }
        }
        if ((lane & 15) == 0) { pm[wave * 4 + hh] = m; pl[wave * 4 + hh] = l; }
        *(LAS f32x4*)(pacc + wave * 256 + hh * 64 + dd) = (f32x4){a0, a1, a2, a3};
    }
    __syncthreads();
    {
        const int tid = wave * 64 + lane;
        if (tid < 256) {
            const int hh = tid >> 6;
            float mm = -1e30f;
#pragma unroll
            for (int w = 0; w < 6; ++w) mm = fmaxf(mm, pm[w * 4 + hh]);
            float ll = 0.f, o = 0.f;
#pragma unroll
            for (int w = 0; w < 6; ++w) { const float e = __expf(pm[w * 4 + hh] - mm); ll += pl[w * 4 + hh] * e; o += pacc[w * 256 + tid] * e; }
            OA[(size_t)(MP + db * 4 + t) * 256 + tid] = (bf16_t)f2bf(o / ll);
        }
    }
    __syncthreads();
}

__device__ __forceinline__ void sgate_sample_item(int db, const KArgs& a, const bf16_t* Z, bf16_t* OB, int lane) {
    const float* lng = a.in[8]; const float* lnb = a.in[9]; const float* Wsp = a.in[10]; const float* bsp = a.in[11];
    float zn[4][8];
    const int gg = lane >> 4;
#pragma unroll
    for (int t = 0; t < 4; ++t) {
        const size_t row = (size_t)MP + db * 4 + t;
        const u32x4 raw = *(const u32x4*)(Z + row * 1024 + 512 + 8 * lane);
        float x[8] = {bflo(raw.x), bfhi(raw.x), bflo(raw.y), bfhi(raw.y), bflo(raw.z), bfhi(raw.z), bflo(raw.w), bfhi(raw.w)};
        float s = 0.f;
#pragma unroll
        for (int e = 0; e < 8; ++e) s += x[e];
        const float mean = wave_sum(s) * (1.f / 512.f); float s2 = 0.f;
#pragma unroll
        for (int e = 0; e < 8; ++e) { x[e] -= mean; s2 += x[e] * x[e]; }
        const float rstd = rsqrtf(wave_sum(s2) * (1.f / 512.f) + EPS);
#pragma unroll
        for (int e = 0; e < 8; ++e) zn[t][e] = x[e] * rstd * lng[8 * lane + e] + lnb[8 * lane + e];
        float* so = a.out + O_SG + (size_t)(db * 4 + t) * 512 + 8 * lane;
        *(f32x4*)so = (f32x4){zn[t][0], zn[t][1], zn[t][2], zn[t][3]}; *(f32x4*)(so + 4) = (f32x4){zn[t][4], zn[t][5], zn[t][6], zn[t][7]};
    }
#pragma unroll
    for (int t = 0; t < 4; ++t) {
        const size_t row = (size_t)MP + db * 4 + t;
        const float bb = bsp[gg * 128 + t];
        float mix[8];
#pragma unroll
        for (int e = 0; e < 8; ++e) mix[e] = bb;
#pragma unroll
        for (int s = 0; s <= t; ++s) { const float w = Wsp[((size_t)gg * 128 + t) * 128 + s];
#pragma unroll
            for (int e = 0; e < 8; ++e) mix[e] += w * zn[s][e]; }
        const u32x4 zw = *(const u32x4*)(Z + row * 1024 + 8 * lane);
        u32x4 w; w.x = cvt_pk_bf16(bflo(zw.x) * mix[0], bfhi(zw.x) * mix[1]); w.y = cvt_pk_bf16(bflo(zw.y) * mix[2], bfhi(zw.y) * mix[3]);
        w.z = cvt_pk_bf16(bflo(zw.z) * mix[4], bfhi(zw.z) * mix[5]); w.w = cvt_pk_bf16(bflo(zw.w) * mix[6], bfhi(zw.w) * mix[7]);
        *(u32x4*)(OB + row * 512 + 8 * lane) = w;
    }
}

#ifndef PHM
#define PHM 0x1fff
#endif
__global__ void __launch_bounds__(512, 2) fwd_megakernel(KArgs a) {
    extern __shared__ __attribute__((aligned(16))) unsigned char lds_raw[];
    cg::grid_group grid = cg::this_grid();
    LAS unsigned char* lds = (LAS unsigned char*)lds_raw;
    const int G = gridDim.x, bid = blockIdx.x, NGW = G * 8;
#define FRESH_IDS int tid_ = threadIdx.x; asm volatile("" : "+v"(tid_)); const int lane = tid_ & 63, wave = __builtin_amdgcn_readfirstlane(tid_ >> 6), gw = bid * 8 + wave; (void)gw; (void)lane;
    unsigned char* ws = a.ws;
    bf16_t* XN = (bf16_t*)(ws + WS_XN); bf16_t* QKV = (bf16_t*)(ws + WS_QKV); bf16_t* VT = (bf16_t*)(ws + WS_VT); bf16_t* Zb = (bf16_t*)(ws + WS_Z);
    bf16_t* Gb = (bf16_t*)(ws + WS_G); bf16_t* OA = (bf16_t*)(ws + WS_OA); bf16_t* OB = (bf16_t*)(ws + WS_OB); float* T = (float*)(ws + WS_T);
    bf16_t* MG = (bf16_t*)(ws + WS_MG); bf16_t* U = (bf16_t*)(ws + WS_U); float* rss = (float*)(ws + WS_RSS);

    if (PHM & 1) { FRESH_IDS p0_prologue(a, lds, wave, lane, gw, NGW); }
    grid.sync();
    if (PHM & 2) {
        pg8::Gemm g{XN, (const bf16_t*)(ws + WS_WIN), MT, NIN, DM}; pg8::StaticOrder S; S.init(MT, NIN, G, bid);
        EpiIn E{QKV, VT, Zb, Gb, a.out, a.in[7]};
        pg8::gemm_phase<EpiIn, pg8::StaticOrder, true, true>(lds, g, S, E);
    }
    grid.sync();
    if (PHM & 4) { FRESH_IDS for (int u = bid; u < 256; u += G) attn_prompt_unit(u, QKV, VT, OA, lds, wave, lane); }
    if (PHM & 8) { FRESH_IDS for (int u = bid; u < 512; u += G) sgate_prompt_unit(u, Zb, a.in[8], a.in[9], a.in[10], a.in[11], OB, lds, wave, lane); }
    if (PHM & 16) { FRESH_IDS for (int it = bid; it < MS; it += G) attn_sample_item(it, a, QKV, OA, lds, wave, lane); }
    if (PHM & 32) { FRESH_IDS for (int db = gw; db < 128; db += NGW) sgate_sample_item(db, a, Zb, OB, lane); }
    grid.sync();
    if (PHM & 64) {
        pg8::Gemm g{OA, (const bf16_t*)(ws + WS_WAO), MT, DM, 256}; pg8::StaticOrder S; S.init(MT, DM, G, bid);
        EpiGateA E{Gb, T};
        pg8::gemm_phase<EpiGateA, pg8::StaticOrder, true, true>(lds, g, S, E);
    }
    if (PHM & 128) {
        pg8::Gemm g{OB, (const bf16_t*)(ws + WS_WBO), MT, DM, 512}; pg8::StaticOrder S; S.init(MT, DM, G, bid);
        EpiGateB E{Gb, T, MG};
        pg8::gemm_phase<EpiGateB, pg8::StaticOrder, true, true>(lds, g, S, E);
    }
    grid.sync();
    if (PHM & 256) {
        pg8::Gemm g{MG, (const bf16_t*)(ws + WS_WOUT), MT, DM, DM}; pg8::StaticOrder S; S.init(MT, DM, G, bid);
        EpiSS E{T, rss};
        pg8::gemm_phase<EpiSS, pg8::StaticOrder, true, true>(lds, g, S, E);
    }
    grid.sync();
    if (PHM & 512) {
        FRESH_IDS
        const float* g1 = a.in[15]; const float* g2 = a.in[16];
        for (int row = gw; row < MT; row += NGW) {
            const f32x4* xr = (const f32x4*)xrow_ptr(a, row) + lane; const f32x4* tr = (const f32x4*)(T + (size_t)row * DM) + lane;
            const float r1 = rsqrtf(rss[row] * (1.f / DM) + EPS);
            f32x4 v[4]; float s = 0.f;
#pragma unroll
            for (int j = 0; j < 4; ++j) { const f32x4 x = xr[64 * j], t = tr[64 * j], g = ((const f32x4*)g1)[lane + 64 * j];
                v[j] = x + t * r1 * g; s += (v[j][0] * v[j][0] + v[j][1] * v[j][1]) + (v[j][2] * v[j][2] + v[j][3] * v[j][3]); }
            const float r2 = rsqrtf(wave_sum(s) * (1.f / DM) + EPS);
            f32x4* yo = (f32x4*)(a.out + O_Y + (size_t)row * DM) + lane; u32x2* ho = (u32x2*)(XN + (size_t)row * DM) + lane;
#pragma unroll
            for (int j = 0; j < 4; ++j) { const f32x4 g = ((const f32x4*)g2)[lane + 64 * j]; yo[64 * j] = v[j];
                u32x2 w; w.x = pk2(v[j][0] * r2 * g[0], v[j][1] * r2 * g[1]); w.y = pk2(v[j][2] * r2 * g[2], v[j][3] * r2 * g[3]); ho[64 * j] = w; }
        }
    }
    grid.sync();
    if (PHM & 1024) {
        pg8::Gemm g{XN, (const bf16_t*)(ws + WS_WUP), MT, FF, DM}; pg8::StaticOrder S; S.init(MT, FF, G, bid);
        EpiUp E{U};
        pg8::gemm_phase<EpiUp, pg8::StaticOrder, true, true>(lds, g, S, E);
    }
    grid.sync();
    if (PHM & 2048) {
        pg8::Gemm g{U, (const bf16_t*)(ws + WS_WDN), MT, DM, FF}; pg8::StaticOrder S; S.init(MT, DM, G, bid);
        EpiSS E{T, rss + MT};
        pg8::gemm_phase<EpiSS, pg8::StaticOrder, true, true>(lds, g, S, E);
    }
    grid.sync();
    if (PHM & 4096) {
        FRESH_IDS
        const float* g3 = a.in[19];
        for (int row = gw; row < MT; row += NGW) {
            const f32x4* tr = (const f32x4*)(T + (size_t)row * DM) + lane; f32x4* yo = (f32x4*)(a.out + O_Y + (size_t)row * DM) + lane;
            const float r3 = rsqrtf(rss[MT + row] * (1.f / DM) + EPS);
#pragma unroll
            for (int j = 0; j < 4; ++j) { const f32x4 g = ((const f32x4*)g3)[lane + 64 * j]; yo[64 * j] = yo[64 * j] + tr[64 * j] * r3 * g; }
        }
    }
}

extern "C" void kernel_launch(void* const* d_in, const int* in_sizes, int n_in, void* d_out, int out_size, void* d_ws, size_t ws_size, hipStream_t stream) {
    static int grid_blocks = 0;
    if (grid_blocks == 0) {
        if (n_in != 20 || ws_size < WS_END) { fprintf(stderr, "kernel_launch: unexpected n_in %d / ws_size %zu (need %zu)\n", n_in, ws_size, (size_t)WS_END); grid_blocks = -1; return; }
        int dev = 0, cus = 0, per_cu = 0;
        (void)hipGetDevice(&dev);
        (void)hipDeviceGetAttribute(&cus, hipDeviceAttributeMultiprocessorCount, dev);
        (void)hipFuncSetAttribute((const void*)fwd_megakernel, hipFuncAttributeMaxDynamicSharedMemorySize, LDS_BYTES);
        (void)hipOccupancyMaxActiveBlocksPerMultiprocessor(&per_cu, (const void*)fwd_megakernel, 512, LDS_BYTES);
        if (per_cu < 1) { fprintf(stderr, "kernel_launch: occupancy query reports %d blocks per CU\n", per_cu); per_cu = 1; }
        if (per_cu > 1) per_cu = 1;
        grid_blocks = cus * per_cu;
    }
    if (grid_blocks < 0) return;
    KArgs a{};
    for (int i = 0; i < 20; ++i) a.in[i] = (const float*)d_in[i];
    a.out = (float*)d_out; a.ws = (unsigned char*)d_ws;
    void* kargs[] = {&a};
    hipError_t e = hipLaunchCooperativeKernel((const void*)fwd_megakernel, dim3(grid_blocks), dim3(512), kargs, LDS_BYTES, stream);
    if (e != hipSuccess) fprintf(stderr, "cooperative launch failed: %s (grid %d)\n", hipGetErrorString(e), grid_blocks);
}
```

```cpp
#include <hip/hip_runtime.h>
#include <hip/hip_cooperative_groups.h>
#include <cstdio>
#include <cstdint>
namespace cg = cooperative_groups;
namespace pg8 {
#define PG8_LAS __attribute__((address_space(3)))
typedef unsigned short bf16_t;
typedef short bf16x8 __attribute__((ext_vector_type(8)));
typedef float f32x4 __attribute__((ext_vector_type(4)));
typedef unsigned u32x4 __attribute__((ext_vector_type(4)));
constexpr int BM = 256, BK = 64, HALF = 128, HTB = HALF * BK * 2  , STAGE_BYTES = 8 * HTB, NXCD = 8, WGM = 8;

__host__ __device__ __forceinline__ int lds_byte(int r, int c) { const int st = (r >> 4) * 2 + (c >> 5), rr = r & 15, cc = c & 31, ob = rr * 64 + cc * 2; return st * 1024 + (ob ^ (((ob >> 9) & 1) << 5)); }
__host__ __device__ __forceinline__ void stage_rc(int b, int& R, int& C) { const int st = b / 1024, sb = b % 1024, swz = sb ^ (((sb >> 9) & 1) << 5); R = (st >> 1) * 16 + swz / 64; C = (st & 1) * 32 + (swz % 64) / 2; }
__host__ __device__ __forceinline__ int perm32(int rho) { const int n = rho >> 4, i = rho & 15; return 8 * (i >> 2) + 4 * n + (i & 3); }

struct Unit { int pm, pn; };
struct Gemm { const bf16_t* A; const bf16_t* Bt; int M, N, K; };

struct StaticOrder {
    int nM, nN, nwg, G, c;
    __host__ __device__ void init(int M, int N, int G_, int c_) { nM = M / BM; nN = N / BM; nwg = nM * nN; G = G_; c = c_; }
    __host__ __device__ bool next(int i, Unit& u) const {
        const long L = (long)i * G + c; if (L >= nwg) return false;
        int wgid = (int)L; { const int q = nwg / NXCD, r = nwg % NXCD, xcd = wgid % NXCD, off = wgid / NXCD; wgid = (xcd < r ? xcd * (q + 1) : r * (q + 1) + (xcd - r) * q) + off; }
        const int nig = WGM * nN, gid = wgid / nig, fm = gid * WGM, gsz = (nM - fm) < WGM ? (nM - fm) : WGM;
        u.pm = fm + ((wgid % nig) % gsz); u.pn = (wgid % nig) / gsz; return true;
    }
    __device__ __forceinline__ void a_ready(const Unit&) const {}
    __device__ __forceinline__ void done(const Unit&) const {}
};
__device__ __forceinline__ unsigned cvt_pk_bf16(float lo, float hi) { unsigned r; asm volatile("v_cvt_pk_bf16_f32 %0, %1, %2" : "=v"(r) : "v"(lo), "v"(hi)); return r; }
typedef float f32x2 __attribute__((ext_vector_type(2)));
template <class Epi, class Sched, bool ALIGN_EPI = false, bool SP2 = false>
__device__ __forceinline__ void gemm_phase(PG8_LAS unsigned char* lds, const Gemm g, const Sched& S, const Epi& E) {
    int tid_ = threadIdx.x; asm volatile("" : "+v"(tid_));
    const int tid = tid_, wid = __builtin_amdgcn_readfirstlane(tid >> 6), lane = tid & 63, wr = wid >> 2, wc = wid & 3, fr = lane & 15, fq = lane >> 4;
    const int K = g.K, nt = K / BK;
    unsigned voffA[2], voffB[2];
#pragma unroll
    for (int i = 0; i < 2; ++i) { int R, C; stage_rc(tid * 16 + i * 8192, R, C); const int Rb = Epi::PERM ? ((R & ~31) + perm32(R & 31)) : R;
        voffA[i] = (unsigned)(R * K + C) * 2u; voffB[i] = (unsigned)(Rb * K + C) * 2u; }
    const size_t kstep = (size_t)(BK * 2);
    const size_t hstep = (size_t)HALF * K * 2;
    const size_t tstep = 2 * hstep;
    const unsigned ldsw = (unsigned)wid * 1024u;
    const int aoff = lds_byte(wr * 64 + fr, fq * 8), boff = lds_byte(wc * 32 + fr, fq * 8);
#define PG8_SA(b, h) (((b) * 2 + (h)) * HTB)
#define PG8_SB(b, h) ((4 + (b) * 2 + (h)) * HTB)
#define PG8_STAGE(bufoff, gbase, voff) do { _Pragma("unroll") for (int _i = 0; _i < 2; ++_i) \
        __builtin_amdgcn_global_load_lds((const unsigned*)((const char*)(gbase) + (voff)[_i]), (PG8_LAS unsigned*)(lds + (bufoff) + ldsw + _i * 8192), 16, 0, 0); } while (0)
#define PG8_LDA(dst, b, h) do { _Pragma("unroll") for (int m = 0; m < 4; ++m) _Pragma("unroll") for (int k = 0; k < 2; ++k) dst[m][k] = *(const PG8_LAS bf16x8*)(lds + PG8_SA(b, h) + aoff + m * 2048 + k * 1024); } while (0)
#define PG8_LDB(dst, b, h) do { _Pragma("unroll") for (int n = 0; n < 2; ++n) _Pragma("unroll") for (int k = 0; k < 2; ++k) dst[n][k] = *(const PG8_LAS bf16x8*)(lds + PG8_SB(b, h) + boff + n * 2048 + k * 1024); } while (0)
#define PG8_MMA(ai, bj, At, Bt) do { __builtin_amdgcn_s_setprio(1); _Pragma("unroll") for (int m = 0; m < 4; ++m) _Pragma("unroll") for (int n = 0; n < 2; ++n) _Pragma("unroll") for (int k = 0; k < 2; ++k) \
        acc[ai][bj][m][n] = __builtin_amdgcn_mfma_f32_16x16x32_bf16(Bt[n][k], At[m][k], acc[ai][bj][m][n], 0, 0, 0); __builtin_amdgcn_s_setprio(0); } while (0)
#define PG8_WAIT_V(n) asm volatile("s_waitcnt vmcnt(" #n ")" ::: "memory")
#define PG8_WAIT_L(n) asm volatile("s_waitcnt lgkmcnt(" #n ")" ::: "memory")
#define PG8_BAR __builtin_amdgcn_s_barrier()
#define PG8_SCHED __builtin_amdgcn_sched_barrier(0)
    Unit cur, nxt; int ui = 0;
    if (!S.next(0, cur)) return;
    f32x4 acc[2][2][4][2];
#pragma unroll
    for (int a = 0; a < 2; ++a)
#pragma unroll
        for (int b = 0; b < 2; ++b)
#pragma unroll
            for (int m = 0; m < 4; ++m)
#pragma unroll
                for (int n = 0; n < 2; ++n) acc[a][b][m][n] = (f32x4){0.f, 0.f, 0.f, 0.f};
    bf16x8 At[4][2], B0[2][2], B1[2][2];
    const char* cA = (const char*)g.A + (size_t)cur.pm * tstep; const char* cB = (const char*)g.Bt + (size_t)cur.pn * tstep;
    S.a_ready(cur);
    if constexpr (SP2) {
        PG8_STAGE(PG8_SB(0, 0), cB, voffB); PG8_STAGE(PG8_SB(0, 1), cB + hstep, voffB); PG8_STAGE(PG8_SA(0, 0), cA, voffA); PG8_STAGE(PG8_SA(0, 1), cA + hstep, voffA);
        if (wr == 1) PG8_BAR;
        PG8_WAIT_V(2); PG8_BAR;
        PG8_STAGE(PG8_SB(1, 0), cB + kstep, voffB); PG8_STAGE(PG8_SA(1, 0), cA + kstep, voffA); PG8_STAGE(PG8_SB(1, 1), cB + hstep + kstep, voffB);
        PG8_WAIT_V(6); PG8_BAR;
    } else {
        PG8_STAGE(PG8_SB(0, 0), cB, voffB); PG8_STAGE(PG8_SA(0, 0), cA, voffA); PG8_STAGE(PG8_SB(0, 1), cB + hstep, voffB); PG8_STAGE(PG8_SA(0, 1), cA + hstep, voffA);
        if (wr == 1) PG8_BAR;
        PG8_WAIT_V(4); PG8_BAR;
        PG8_STAGE(PG8_SB(1, 0), cB + kstep, voffB); PG8_STAGE(PG8_SA(1, 0), cA + kstep, voffA); PG8_STAGE(PG8_SB(1, 1), cB + hstep + kstep, voffB);
        PG8_WAIT_V(6); PG8_BAR;
    }
    for (;;) {
        const bool has_next = S.next(ui + 1, nxt);
        const char* nA = has_next ? (const char*)g.A + (size_t)nxt.pm * tstep : cA; const char* nB = has_next ? (const char*)g.Bt + (size_t)nxt.pn * tstep : cB;
        for (int t = 0; t < nt; t += 2) {
            const bool last = (t == nt - 2);
            const char* a1 = cA + (size_t)(t + 1) * kstep;
            const char* a2 = last ? nA : cA + (size_t)(t + 2) * kstep; const char* b2 = last ? nB : cB + (size_t)(t + 2) * kstep;
            const char* a3 = a2 + kstep; const char* b3 = b2 + kstep;
            if (last && has_next) S.a_ready(nxt);
            if constexpr (SP2) {
            PG8_LDB(B0, 0, 0); PG8_LDB(B1, 0, 1); PG8_SCHED; PG8_LDA(At, 0, 0); PG8_STAGE(PG8_SA(1, 1), a1 + hstep, voffA);
            PG8_WAIT_V(8); PG8_WAIT_L(0); PG8_BAR; PG8_MMA(0, 0, At, B0); PG8_MMA(0, 1, At, B1); PG8_BAR; PG8_SCHED;
            PG8_LDA(At, 0, 1); PG8_STAGE(PG8_SB(0, 0), b2, voffB); PG8_STAGE(PG8_SB(0, 1), b2 + hstep, voffB); PG8_STAGE(PG8_SA(0, 0), a2, voffA);
            PG8_WAIT_V(8); PG8_WAIT_L(0); PG8_BAR; PG8_MMA(1, 0, At, B0); PG8_MMA(1, 1, At, B1); PG8_BAR; PG8_SCHED;
            PG8_LDB(B0, 1, 0); PG8_LDB(B1, 1, 1); PG8_SCHED; PG8_LDA(At, 1, 0); PG8_STAGE(PG8_SA(0, 1), a2 + hstep, voffA);
            PG8_WAIT_V(8); PG8_WAIT_L(0); PG8_BAR; PG8_MMA(0, 0, At, B0); PG8_MMA(0, 1, At, B1); PG8_BAR; PG8_SCHED;
            PG8_LDA(At, 1, 1); PG8_STAGE(PG8_SB(1, 0), b3, voffB); PG8_STAGE(PG8_SB(1, 1), b3 + hstep, voffB); PG8_STAGE(PG8_SA(1, 0), a3, voffA);
            PG8_WAIT_V(8); PG8_WAIT_L(0); PG8_BAR; PG8_MMA(1, 0, At, B0); PG8_MMA(1, 1, At, B1); PG8_BAR; PG8_SCHED;
            } else {
            PG8_LDB(B0, 0, 0); PG8_SCHED; PG8_LDA(At, 0, 0); PG8_STAGE(PG8_SA(1, 1), a1 + hstep, voffA);
            PG8_WAIT_L(8); PG8_BAR; PG8_WAIT_L(0); PG8_MMA(0, 0, At, B0); PG8_BAR; PG8_SCHED;
            PG8_LDB(B1, 0, 1); PG8_STAGE(PG8_SB(0, 0), b2, voffB);
            PG8_BAR; PG8_WAIT_L(0); PG8_MMA(0, 1, At, B1); PG8_BAR;
            PG8_LDA(At, 0, 1); PG8_STAGE(PG8_SA(0, 0), a2, voffA);
            PG8_BAR; PG8_WAIT_L(0); PG8_MMA(1, 0, At, B0); PG8_BAR; PG8_SCHED;
            PG8_STAGE(PG8_SB(0, 1), b2 + hstep, voffB);
            PG8_WAIT_V(6); PG8_BAR; PG8_MMA(1, 1, At, B1); PG8_BAR;
            PG8_LDB(B0, 1, 0); PG8_SCHED; PG8_LDA(At, 1, 0); PG8_STAGE(PG8_SA(0, 1), a2 + hstep, voffA);
            PG8_WAIT_L(8); PG8_BAR; PG8_WAIT_L(0); PG8_MMA(0, 0, At, B0); PG8_BAR; PG8_SCHED;
            PG8_LDB(B1, 1, 1); PG8_STAGE(PG8_SB(1, 0), b3, voffB);
            PG8_BAR; PG8_WAIT_L(0); PG8_MMA(0, 1, At, B1); PG8_BAR;
            PG8_LDA(At, 1, 1); PG8_STAGE(PG8_SA(1, 0), a3, voffA);
            PG8_BAR; PG8_WAIT_L(0); PG8_MMA(1, 0, At, B0); PG8_BAR; PG8_SCHED;
            PG8_STAGE(PG8_SB(1, 1), b3 + hstep, voffB);
            PG8_WAIT_V(6); PG8_BAR; PG8_MMA(1, 1, At, B1); PG8_BAR;
            }
        }
        if constexpr (ALIGN_EPI) { if (wr == 0) PG8_BAR; }
        if constexpr (!Epi::AFTER_DRAIN) { E(acc, cur, wr, wc, fr, fq); S.done(cur); }
        if (!has_next) break;
#pragma unroll
        for (int a = 0; a < 2; ++a)
#pragma unroll
            for (int b = 0; b < 2; ++b)
#pragma unroll
                for (int m = 0; m < 4; ++m)
#pragma unroll
                    for (int n = 0; n < 2; ++n) acc[a][b][m][n] = (f32x4){0.f, 0.f, 0.f, 0.f};
        cur = nxt; cA = nA; cB = nB; ++ui;
        if constexpr (ALIGN_EPI) { if (wr == 1) PG8_BAR; }
    }
    PG8_WAIT_V(0);
    if constexpr (!ALIGN_EPI) { if (wr == 0) PG8_BAR; }
    PG8_BAR;
    if constexpr (Epi::AFTER_DRAIN) { E.fused(acc, cur, wr, wc, fr, fq, lds, wid, lane); S.done(cur); }
#undef PG8_SA
#undef PG8_SB
#undef PG8_STAGE
#undef PG8_LDA
#undef PG8_LDB
#undef PG8_MMA
#undef PG8_WAIT_V
#undef PG8_WAIT_L
#undef PG8_BAR
#undef PG8_SCHED
}
}

using pg8::bf16_t; using pg8::bf16x8; using pg8::f32x4; using pg8::u32x4; using pg8::Unit; using pg8::cvt_pk_bf16;
#define LAS __attribute__((address_space(3)))
typedef unsigned long long u64;
typedef unsigned u32x2 __attribute__((ext_vector_type(2)));

constexpr int MP = 16384, MS = 512, MT = MP + MS;
constexpr int DM = 1024, NIN = 5376, FF = 4096, NQKV = 2304;
constexpr float EPS = 1e-6f, SCALE = 0.125f, LOG2E = 1.4426950408889634f;
constexpr size_t O_Y = 0, O_KVP0 = 17301504, O_KVP1 = 17825792, O_KVP2 = 19922944, O_KVS0 = 28311552, O_KVS1 = 28573696, O_KVS2 = 28835840, O_SG = 29097984;
constexpr size_t al(size_t x) { return (x + 4095) & ~(size_t)4095; }
constexpr size_t WS_BAR   = 0;
constexpr size_t WS_RSS   = 16384;
constexpr size_t WS_WIN   = al(WS_RSS + 2 * MT * 4);
constexpr size_t WS_WAO   = al(WS_WIN + (size_t)NIN * DM * 2);
constexpr size_t WS_WBO   = al(WS_WAO + (size_t)DM * 256 * 2);
constexpr size_t WS_WOUT  = al(WS_WBO + (size_t)DM * 512 * 2);
constexpr size_t WS_WUP   = al(WS_WOUT + (size_t)DM * DM * 2);
constexpr size_t WS_WDN   = al(WS_WUP + (size_t)FF * DM * 2);
constexpr size_t WS_XN    = al(WS_WDN + (size_t)DM * FF * 2);
constexpr size_t WS_QKV   = al(WS_XN + (size_t)MT * DM * 2);
constexpr size_t WS_VT    = al(WS_QKV + (size_t)MT * NQKV * 2);
constexpr size_t WS_Z     = al(WS_VT + (size_t)8 * 3 * 4 * 64 * 2048 * 2);
constexpr size_t WS_G     = al(WS_Z + (size_t)MT * 1024 * 2);
constexpr size_t WS_OA    = al(WS_G + (size_t)MT * 2048 * 2);
constexpr size_t WS_OB    = al(WS_OA + (size_t)MT * 256 * 2);
constexpr size_t WS_T     = al(WS_OB + (size_t)MT * 512 * 2);
constexpr size_t WS_MG    = al(WS_T + (size_t)MT * DM * 4);
constexpr size_t WS_U     = al(WS_MG + (size_t)MT * DM * 2);
constexpr size_t WS_END   = al(WS_U + (size_t)MT * FF * 2);
constexpr int LDS_BYTES = 147456;

__device__ __forceinline__ float bf2f(unsigned short h) { return __builtin_bit_cast(float, (unsigned)h << 16); }
__device__ __forceinline__ float bflo(unsigned w) { return __builtin_bit_cast(float, w << 16); }
__device__ __forceinline__ float bfhi(unsigned w) { return __builtin_bit_cast(float, w & 0xffff0000u); }
__device__ __forceinline__ unsigned f2bf(float f) { unsigned u = __builtin_bit_cast(unsigned, f); return (u + 0x7fffu + ((u >> 16) & 1u)) >> 16; }
__device__ __forceinline__ unsigned pk2(float lo, float hi) { return f2bf(lo) | (f2bf(hi) << 16); }
__device__ __forceinline__ float wave_sum(float v) {
#pragma unroll
    for (int o = 1; o < 64; o <<= 1) v += __shfl_xor(v, o);
    return v;
}
__device__ __forceinline__ f32x4 mfma16(bf16x8 a, bf16x8 b, f32x4 c) { return __builtin_amdgcn_mfma_f32_16x16x32_bf16(a, b, c, 0, 0, 0); }

#define EPI_LOOP for (int ai = 0; ai < 2; ++ai) _Pragma("unroll") for (int m = 0; m < 4; ++m) _Pragma("unroll") for (int bj = 0; bj < 2; ++bj)

struct EpiIn {
    static constexpr bool PERM = true, AFTER_DRAIN = false;
    bf16_t* QKV; bf16_t* VT; bf16_t* Z; bf16_t* G; float* out; const float* bgate;
    __device__ __forceinline__ void operator()(const f32x4 (&acc)[2][2][4][2], const Unit& u, int wr, int wc, int fr, int fq) const {
        const int pn = u.pn, row0 = u.pm * 256 + wr * 64 + fr, cl0 = wc * 32 + 8 * fq;
        if (pn < 9) {
            const int g = pn % 3, kvsel = (pn >= 6) ? 1 : 0, sh = 2 * g;
#pragma unroll
            EPI_LOOP {
                const int row = row0 + ai * 128 + m * 16, cl = cl0 + bj * 128;
                const f32x4 v0 = acc[ai][bj][m][0], v1 = acc[ai][bj][m][1];
                u32x4 w; w.x = cvt_pk_bf16(v0[0], v0[1]); w.y = cvt_pk_bf16(v0[2], v0[3]); w.z = cvt_pk_bf16(v1[0], v1[1]); w.w = cvt_pk_bf16(v1[2], v1[3]);
                *(u32x4*)(QKV + (size_t)row * NQKV + pn * 256 + cl) = w;
                if (pn >= 3) {
                    float* dst = nullptr;
                    if (row < MP) {
                        const int b = row >> 11, s = row & 2047;
                        if (g == 0) { if (s >= 1920) dst = out + O_KVP0 + ((size_t)(b * 128 + s - 1920) * 2 + kvsel) * 256; }
                        else if (g == 1) { if (s >= 1536) dst = out + O_KVP1 + ((size_t)(b * 512 + s - 1536) * 2 + kvsel) * 256; }
                        else dst = out + O_KVP2 + ((size_t)(b * 2048 + s) * 2 + kvsel) * 256;
                        if (pn >= 6) {
                            const int r = s & ((1 << sh) - 1), mm = s >> sh, L = 2048 >> sh;
                            bf16_t* vt = VT + ((size_t)((b * 3 + g) * 256 + cl)) * 2048 + r * L + mm;
                            vt[0 * 2048] = (bf16_t)(w.x & 0xffff); vt[1 * 2048] = (bf16_t)(w.x >> 16); vt[2 * 2048] = (bf16_t)(w.y & 0xffff); vt[3 * 2048] = (bf16_t)(w.y >> 16);
                            vt[4 * 2048] = (bf16_t)(w.z & 0xffff); vt[5 * 2048] = (bf16_t)(w.z >> 16); vt[6 * 2048] = (bf16_t)(w.w & 0xffff); vt[7 * 2048] = (bf16_t)(w.w >> 16);
                        }
                    } else {
                        const int rs = row - MP;
                        dst = out + (g == 0 ? O_KVS0 : (g == 1 ? O_KVS1 : O_KVS2)) + ((size_t)rs * 2 + kvsel) * 256;
                    }
                    if (dst) { *(f32x4*)(dst + cl) = v0; *(f32x4*)(dst + cl + 4) = v1; }
                }
            }
        } else if (pn < 13) {
#pragma unroll
            EPI_LOOP {
                const int row = row0 + ai * 128 + m * 16, cl = cl0 + bj * 128;
                f32x4 v0 = acc[ai][bj][m][0], v1 = acc[ai][bj][m][1];
#pragma unroll
                for (int e = 0; e < 4; ++e) { v0[e] = 0.5f * v0[e] * (1.f + erff(v0[e] * 0.70710678118654752f)); v1[e] = 0.5f * v1[e] * (1.f + erff(v1[e] * 0.70710678118654752f)); }
                u32x4 w; w.x = cvt_pk_bf16(v0[0], v0[1]); w.y = cvt_pk_bf16(v0[2], v0[3]); w.z = cvt_pk_bf16(v1[0], v1[1]); w.w = cvt_pk_bf16(v1[2], v1[3]);
                *(u32x4*)(Z + (size_t)row * 1024 + (pn - 9) * 256 + cl) = w;
            }
        } else {
#pragma unroll
            EPI_LOOP {
                const int row = row0 + ai * 128 + m * 16, cg_ = (pn - 13) * 256 + cl0 + bj * 128;
                const f32x4 b0 = *(const f32x4*)(bgate + cg_), b1 = *(const f32x4*)(bgate + cg_ + 4);
                f32x4 v0 = acc[ai][bj][m][0] + b0, v1 = acc[ai][bj][m][1] + b1;
#pragma unroll
                for (int e = 0; e < 4; ++e) { v0[e] = 1.f / (1.f + __expf(-v0[e])); v1[e] = 1.f / (1.f + __expf(-v1[e])); }
                u32x4 w; w.x = cvt_pk_bf16(v0[0], v0[1]); w.y = cvt_pk_bf16(v0[2], v0[3]); w.z = cvt_pk_bf16(v1[0], v1[1]); w.w = cvt_pk_bf16(v1[2], v1[3]);
                *(u32x4*)(G + (size_t)row * 2048 + cg_) = w;
            }
        }
    }
};

struct EpiGateA {
    static constexpr bool PERM = true, AFTER_DRAIN = false;
    const bf16_t* G; float* T;
    __device__ __forceinline__ void operator()(const f32x4 (&acc)[2][2][4][2], const Unit& u, int wr, int wc, int fr, int fq) const {
        const int row0 = u.pm * 256 + wr * 64 + fr, c0 = u.pn * 256 + wc * 32 + 8 * fq;
#pragma unroll
        EPI_LOOP {
            const int row = row0 + ai * 128 + m * 16, col = c0 + bj * 128;
            const u32x4 gw = *(const u32x4*)(G + (size_t)row * 2048 + col);
            f32x4 v0 = acc[ai][bj][m][0], v1 = acc[ai][bj][m][1];
            v0[0] *= bflo(gw.x); v0[1] *= bfhi(gw.x); v0[2] *= bflo(gw.y); v0[3] *= bfhi(gw.y);
            v1[0] *= bflo(gw.z); v1[1] *= bfhi(gw.z); v1[2] *= bflo(gw.w); v1[3] *= bfhi(gw.w);
            float* t = T + (size_t)row * DM + col;
            *(f32x4*)t = v0; *(f32x4*)(t + 4) = v1;
        }
    }
};
struct EpiGateB {
    static constexpr bool PERM = true, AFTER_DRAIN = false;
    const bf16_t* G; const float* T; bf16_t* MG;
    __device__ __forceinline__ void operator()(const f32x4 (&acc)[2][2][4][2], const Unit& u, int wr, int wc, int fr, int fq) const {
        const int row0 = u.pm * 256 + wr * 64 + fr, c0 = u.pn * 256 + wc * 32 + 8 * fq;
#pragma unroll
        EPI_LOOP {
            const int row = row0 + ai * 128 + m * 16, col = c0 + bj * 128;
            const u32x4 gw = *(const u32x4*)(G + (size_t)row * 2048 + 1024 + col);
            const float* t = T + (size_t)row * DM + col;
            f32x4 v0 = *(const f32x4*)t, v1 = *(const f32x4*)(t + 4);
            const f32x4 a0 = acc[ai][bj][m][0], a1 = acc[ai][bj][m][1];
            v0[0] += a0[0] * bflo(gw.x); v0[1] += a0[1] * bfhi(gw.x); v0[2] += a0[2] * bflo(gw.y); v0[3] += a0[3] * bfhi(gw.y);
            v1[0] += a1[0] * bflo(gw.z); v1[1] += a1[1] * bfhi(gw.z); v1[2] += a1[2] * bflo(gw.w); v1[3] += a1[3] * bfhi(gw.w);
            u32x4 w; w.x = cvt_pk_bf16(v0[0], v0[1]); w.y = cvt_pk_bf16(v0[2], v0[3]); w.z = cvt_pk_bf16(v1[0], v1[1]); w.w = cvt_pk_bf16(v1[2], v1[3]);
            *(u32x4*)(MG + (size_t)row * DM + col) = w;
        }
    }
};
struct EpiSS {
    static constexpr bool PERM = true, AFTER_DRAIN = false;
    float* T; float* rss;
    __device__ __forceinline__ void operator()(const f32x4 (&acc)[2][2][4][2], const Unit& u, int wr, int wc, int fr, int fq) const {
        const int row0 = u.pm * 256 + wr * 64 + fr, c0 = u.pn * 256 + wc * 32 + 8 * fq;
#pragma unroll
        for (int ai = 0; ai < 2; ++ai)
#pragma unroll
            for (int m = 0; m < 4; ++m) {
                const int row = row0 + ai * 128 + m * 16; float s = 0.f;
#pragma unroll
                for (int bj = 0; bj < 2; ++bj) {
                    const f32x4 v0 = acc[ai][bj][m][0], v1 = acc[ai][bj][m][1];
                    float* t = T + (size_t)row * DM + c0 + bj * 128;
                    *(f32x4*)t = v0; *(f32x4*)(t + 4) = v1;
                    s += (v0[0] * v0[0] + v0[1] * v0[1]) + (v0[2] * v0[2] + v0[3] * v0[3]) + (v1[0] * v1[0] + v1[1] * v1[1]) + (v1[2] * v1[2] + v1[3] * v1[3]);
                }
                s += __shfl_xor(s, 16); s += __shfl_xor(s, 32);
                if (fq == 0) atomicAdd(rss + row, s);
            }
    }
};
struct EpiUp {
    static constexpr bool PERM = true, AFTER_DRAIN = false;
    bf16_t* U;
    __device__ __forceinline__ void operator()(const f32x4 (&acc)[2][2][4][2], const Unit& u, int wr, int wc, int fr, int fq) const {
        const int row0 = u.pm * 256 + wr * 64 + fr, c0 = u.pn * 256 + wc * 32 + 8 * fq;
#pragma unroll
        EPI_LOOP {
            const int row = row0 + ai * 128 + m * 16, col = c0 + bj * 128;
            f32x4 v0 = acc[ai][bj][m][0], v1 = acc[ai][bj][m][1];
#pragma unroll
            for (int e = 0; e < 4; ++e) { const float a = fmaxf(v0[e], 0.f), b = fmaxf(v1[e], 0.f); v0[e] = a * a; v1[e] = b * b; }
            u32x4 w; w.x = cvt_pk_bf16(v0[0], v0[1]); w.y = cvt_pk_bf16(v0[2], v0[3]); w.z = cvt_pk_bf16(v1[0], v1[1]); w.w = cvt_pk_bf16(v1[2], v1[3]);
            *(u32x4*)(U + (size_t)row * FF + col) = w;
        }
    }
};

__device__ __forceinline__ void p0_transpose_item(const float* W, int K, int N, bf16_t* WT, LAS float* scr, int item, int lane) {
    const int nblk = N / 32, kb = item / nblk, nb = item % nblk, k0 = 64 * kb, n0 = 32 * nb;
#pragma unroll 8
    for (int i = 0; i < 32; ++i) { const int kk = 2 * i + (lane >> 5); scr[kk * 33 + (lane & 31)] = W[(size_t)(k0 + kk) * N + n0 + (lane & 31)]; }
    asm volatile("s_waitcnt lgkmcnt(0)" ::: "memory");
    const int c = lane & 7;
#pragma unroll
    for (int j = 0; j < 4; ++j) { const int n = (lane >> 3) + 8 * j; const LAS float* s = scr + (8 * c) * 33 + n;
        u32x4 o; o.x = pk2(s[0 * 33], s[1 * 33]); o.y = pk2(s[2 * 33], s[3 * 33]); o.z = pk2(s[4 * 33], s[5 * 33]); o.w = pk2(s[6 * 33], s[7 * 33]);
        *(u32x4*)(WT + (size_t)(n0 + n) * K + k0 + 8 * c) = o; }
    asm volatile("s_waitcnt lgkmcnt(0)" ::: "memory");
}

struct KArgs { const float* in[20]; float* out; unsigned char* ws; };

__device__ __forceinline__ const float* xrow_ptr(const KArgs& a, int row) { return row < MP ? a.in[0] + (size_t)row * DM : a.in[1] + (size_t)(row - MP) * DM; }

__device__ __forceinline__ void p0_prologue(const KArgs& a, LAS unsigned char* lds, int wave, int lane, int gw, int NGW) {
    unsigned char* ws = a.ws;
    LAS float* scr = (LAS float*)(lds + wave * 16384);
    constexpr int I0 = (1024 / 64) * (NIN / 32), I1 = (256 / 64) * (1024 / 32), I2 = (512 / 64) * (1024 / 32), I3 = (1024 / 64) * (1024 / 32), I4 = (1024 / 64) * (FF / 32), I5 = (FF / 64) * (1024 / 32);
    constexpr int NIT = I0 + I1 + I2 + I3 + I4 + I5;
    for (int it = gw; it < NIT; it += NGW) {
        int r = it;
        if (r < I0) { p0_transpose_item(a.in[6], 1024, NIN, (bf16_t*)(ws + WS_WIN), scr, r, lane); continue; } r -= I0;
        if (r < I1) { p0_transpose_item(a.in[12], 256, 1024, (bf16_t*)(ws + WS_WAO), scr, r, lane); continue; } r -= I1;
        if (r < I2) { p0_transpose_item(a.in[13], 512, 1024, (bf16_t*)(ws + WS_WBO), scr, r, lane); continue; } r -= I2;
        if (r < I3) { p0_transpose_item(a.in[14], 1024, 1024, (bf16_t*)(ws + WS_WOUT), scr, r, lane); continue; } r -= I3;
        if (r < I4) { p0_transpose_item(a.in[17], 1024, FF, (bf16_t*)(ws + WS_WUP), scr, r, lane); continue; } r -= I4;
        p0_transpose_item(a.in[18], FF, 1024, (bf16_t*)(ws + WS_WDN), scr, r, lane);
    }
    const float* gain = a.in[5];
    bf16_t* XN = (bf16_t*)(ws + WS_XN);
    for (int row = gw; row < MT; row += NGW) {
        const f32x4* xr = (const f32x4*)xrow_ptr(a, row) + lane;
        f32x4 v[4]; float s = 0.f;
#pragma unroll
        for (int j = 0; j < 4; ++j) { v[j] = xr[64 * j]; s += (v[j][0] * v[j][0] + v[j][1] * v[j][1]) + (v[j][2] * v[j][2] + v[j][3] * v[j][3]); }
        const float r = rsqrtf(wave_sum(s) * (1.f / DM) + EPS);
        u32x2* o = (u32x2*)(XN + (size_t)row * DM) + lane;
#pragma unroll
        for (int j = 0; j < 4; ++j) { const f32x4 g = ((const f32x4*)gain)[lane + 64 * j]; u32x2 w; w.x = pk2(v[j][0] * r * g[0], v[j][1] * r * g[1]); w.y = pk2(v[j][2] * r * g[2], v[j][3] * r * g[3]); o[64 * j] = w; }
    }
    float* rss = (float*)(ws + WS_RSS);
    for (int i = gw * 64 + lane; i < 2 * MT; i += NGW * 64) rss[i] = 0.f;
}

constexpr int OST_ROW = 136;
__device__ __forceinline__ void attn_prompt_unit(int u, const bf16_t* QKV, const bf16_t* VT, bf16_t* OA, LAS unsigned char* lds, int wave, int lane) {
    const int b = u >> 5, blk = (u >> 2) & 7, h = u & 3, s0 = blk * 256;
    const int q = lane & 15, c = lane >> 4;
    LAS float* lse_s = (LAS float*)(lds + 3 * 256 * OST_ROW);
    for (int jj = 0; jj < 6; ++jj) {
        const int g = jj >> 1, sub = 2 * wave + (jj & 1), sh = 2 * g, L = 2048 >> sh;
        int r, m0;
        if (g == 0) { r = 0; m0 = s0 + 16 * sub; } else if (g == 1) { r = sub >> 2; m0 = (s0 >> 2) + 16 * (sub & 3); } else { r = sub; m0 = s0 >> 4; }
        const int ktmin = 9 - (m0 >> 4);
        const bf16_t* qrow = QKV + (size_t)(b * 2048 + ((m0 + q) << sh) + r) * NQKV + g * 256 + h * 64 + 8 * c;
        const bf16x8 qf0 = *(const bf16x8*)qrow, qf1 = *(const bf16x8*)(qrow + 32);
        f32x4 st[9];
#pragma unroll
        for (int kt = 1; kt <= 9; ++kt) {
            f32x4 sa = {-1e30f, -1e30f, -1e30f, -1e30f};
            if (kt >= ktmin) {
                const int mk = m0 - 144 + 16 * kt + q;
                const bf16_t* krow = QKV + (size_t)(b * 2048 + (mk << sh) + r) * NQKV + 768 + g * 256 + h * 64 + 8 * c;
                const bf16x8 k0 = *(const bf16x8*)krow, k1 = *(const bf16x8*)(krow + 32);
                f32x4 z = {0.f, 0.f, 0.f, 0.f};
                z = mfma16(k0, qf0, z); z = mfma16(k1, qf1, z);
                if (kt == 1) {
#pragma unroll
                    for (int i = 0; i < 4; ++i) if (4 * c + i < q) z[i] = -1e30f;
                }
                if (kt == 9) {
#pragma unroll
                    for (int i = 0; i < 4; ++i) if (4 * c + i > q) z[i] = -1e30f;
                }
                sa = z;
            }
            st[kt - 1] = sa;
        }
        float mx = -1e30f;
#pragma unroll
        for (int t = 0; t < 9; ++t) mx = fmaxf(mx, fmaxf(fmaxf(st[t][0], st[t][1]), fmaxf(st[t][2], st[t][3])));
        mx = fmaxf(mx, __shfl_xor(mx, 16)); mx = fmaxf(mx, __shfl_xor(mx, 32));
        float ls = 0.f;
#pragma unroll
        for (int t = 0; t < 9; ++t)
#pragma unroll
            for (int i = 0; i < 4; ++i) { const float p = exp2f((st[t][i] - mx) * (SCALE * LOG2E)); st[t][i] = p; ls += p; }
        ls += __shfl_xor(ls, 16); ls += __shfl_xor(ls, 32);
        bf16x8 pf[5];
#pragma unroll
        for (int kb = 0; kb < 5; ++kb) {
            u32x4 w;
            if (kb == 0) { w.x = 0u; w.y = 0u; } else { w.x = cvt_pk_bf16(st[2 * kb - 1][0], st[2 * kb - 1][1]); w.y = cvt_pk_bf16(st[2 * kb - 1][2], st[2 * kb - 1][3]); }
            w.z = cvt_pk_bf16(st[2 * kb][0], st[2 * kb][1]); w.w = cvt_pk_bf16(st[2 * kb][2], st[2 * kb][3]);
            pf[kb] = __builtin_bit_cast(bf16x8, w);
        }
        f32x4 oacc[4];
#pragma unroll
        for (int dt = 0; dt < 4; ++dt) {
            f32x4 o = {0.f, 0.f, 0.f, 0.f};
            const bf16_t* vrow = VT + (size_t)(((b * 3 + g) * 4 + h) * 64 + 16 * dt + q) * 2048 + r * L + 4 * c;
#pragma unroll
            for (int kb = 0; kb < 5; ++kb) {
                if (2 * kb + 1 >= ktmin) {
                    const int mA = m0 - 144 + 32 * kb;
                    u32x2 lo = {0u, 0u}, hi;
                    if (kb > 0 && 2 * kb >= ktmin) lo = *(const u32x2*)(vrow + mA);
                    hi = *(const u32x2*)(vrow + mA + 16);
                    u32x4 w; w.x = lo.x; w.y = lo.y; w.z = hi.x; w.w = hi.y;
                    o = mfma16(__builtin_bit_cast(bf16x8, w), pf[kb], o);
                }
            }
            oacc[dt] = o;
        }
        const float inv = 1.f / ls;
        const int tok = ((m0 + q) << sh) + r - s0;
        LAS unsigned char* orow = lds + (g * 256 + tok) * OST_ROW + 8 * c;
#pragma unroll
        for (int dt = 0; dt < 4; ++dt) {
            u32x2 w; w.x = cvt_pk_bf16(oacc[dt][0] * inv, oacc[dt][1] * inv); w.y = cvt_pk_bf16(oacc[dt][2] * inv, oacc[dt][3] * inv);
            *(LAS u32x2*)(orow + 32 * dt) = w;
        }
        if (c == 0) lse_s[g * 256 + tok] = mx * SCALE + __logf(ls);
    }
    __syncthreads();
    {
        const int tid = wave * 64 + lane, tok = tid >> 1, half = tid & 1;
        const float l0 = lse_s[tok], l1 = lse_s[256 + tok], l2 = lse_s[512 + tok];
        const float mm = fmaxf(l0, fmaxf(l1, l2));
        float e0 = __expf(l0 - mm), e1 = __expf(l1 - mm), e2 = __expf(l2 - mm);
        const float inv = 1.f / (e0 + e1 + e2); e0 *= inv; e1 *= inv; e2 *= inv;
        bf16_t* dst = OA + (size_t)(b * 2048 + s0 + tok) * 256 + h * 64 + half * 32;
#pragma unroll
        for (int ch = 0; ch < 4; ++ch) {
            float o[8];
#pragma unroll
            for (int k2 = 0; k2 < 2; ++k2) {
                const int off = tok * OST_ROW + half * 64 + ch * 16 + k2 * 8;
                const u32x2 a0 = *(const LAS u32x2*)(lds + off), a1 = *(const LAS u32x2*)(lds + 256 * OST_ROW + off), a2 = *(const LAS u32x2*)(lds + 512 * OST_ROW + off);
                o[4 * k2 + 0] = e0 * bflo(a0.x) + e1 * bflo(a1.x) + e2 * bflo(a2.x); o[4 * k2 + 1] = e0 * bfhi(a0.x) + e1 * bfhi(a1.x) + e2 * bfhi(a2.x);
                o[4 * k2 + 2] = e0 * bflo(a0.y) + e1 * bflo(a1.y) + e2 * bflo(a2.y); o[4 * k2 + 3] = e0 * bfhi(a0.y) + e1 * bfhi(a1.y) + e2 * bfhi(a2.y);
            }
            u32x4 w; w.x = cvt_pk_bf16(o[0], o[1]); w.y = cvt_pk_bf16(o[2], o[3]); w.z = cvt_pk_bf16(o[4], o[5]); w.w = cvt_pk_bf16(o[6], o[7]);
            *(u32x4*)(dst + 8 * ch) = w;
        }
    }
    __syncthreads();
}

constexpr int ZT_ROW = 272;
__device__ __forceinline__ void sgate_prompt_unit(int u, const bf16_t* Z, const float* lng, const float* lnb, const float* Wsp, const float* bsp, bf16_t* OB, LAS unsigned char* lds, int wave, int lane) {
    const int chunk = u >> 2, gg = u & 3;
    for (int i = 0; i < 16; ++i) {
        const int tok = wave * 16 + i; const size_t row = (size_t)chunk * 128 + tok;
        const u32x4 raw = *(const u32x4*)(Z + row * 1024 + 512 + 8 * lane);
        float x[8] = {bflo(raw.x), bfhi(raw.x), bflo(raw.y), bfhi(raw.y), bflo(raw.z), bfhi(raw.z), bflo(raw.w), bfhi(raw.w)};
        float s = 0.f;
#pragma unroll
        for (int e = 0; e < 8; ++e) s += x[e];
        const float mean = wave_sum(s) * (1.f / 512.f); float s2 = 0.f;
#pragma unroll
        for (int e = 0; e < 8; ++e) { x[e] -= mean; s2 += x[e] * x[e]; }
        const float rstd = rsqrtf(wave_sum(s2) * (1.f / 512.f) + EPS);
        if ((lane >> 4) == gg) {
            const int fl = 8 * (lane & 15);
#pragma unroll
            for (int e = 0; e < 8; ++e) { const float zn = x[e] * rstd * lng[8 * lane + e] + lnb[8 * lane + e]; *(LAS bf16_t*)(lds + (fl + e) * ZT_ROW + tok * 2) = (bf16_t)f2bf(zn); }
        }
    }
    __syncthreads();
    const int q = lane & 15, c = lane >> 4, t = wave * 16 + q;
    f32x4 acc[8];
#pragma unroll
    for (int kt = 0; kt < 8; ++kt) acc[kt] = (f32x4){0.f, 0.f, 0.f, 0.f};
    const int nks = (wave >> 1) + 1;
    for (int ks = 0; ks < nks; ++ks) {
        const float* wp = Wsp + ((size_t)gg * 128 + t) * 128 + 32 * ks + 8 * c;
        f32x4 w0 = *(const f32x4*)wp, w1 = *(const f32x4*)(wp + 4);
        const int sb = 32 * ks + 8 * c;
#pragma unroll
        for (int e = 0; e < 4; ++e) { if (sb + e > t) w0[e] = 0.f; if (sb + 4 + e > t) w1[e] = 0.f; }
        u32x4 aw; aw.x = cvt_pk_bf16(w0[0], w0[1]); aw.y = cvt_pk_bf16(w0[2], w0[3]); aw.z = cvt_pk_bf16(w1[0], w1[1]); aw.w = cvt_pk_bf16(w1[2], w1[3]);
        const bf16x8 af = __builtin_bit_cast(bf16x8, aw);
#pragma unroll
        for (int kt = 0; kt < 8; ++kt) {
            const bf16x8 bfr = *(const LAS bf16x8*)(lds + (16 * kt + q) * ZT_ROW + sb * 2);
            acc[kt] = mfma16(af, bfr, acc[kt]);
        }
    }
#pragma unroll
    for (int i = 0; i < 4; ++i) {
        const int tt = wave * 16 + 4 * c + i; const size_t row = (size_t)chunk * 128 + tt; const float bb = bsp[gg * 128 + tt];
#pragma unroll
        for (int kt = 0; kt < 8; ++kt) {
            const int col = gg * 128 + 16 * kt + q;
            const float z1 = bf2f(Z[row * 1024 + col]);
            OB[row * 512 + col] = (bf16_t)f2bf(z1 * (acc[kt][i] + bb));
        }
    }
    __syncthreads();
}

__device__ __forceinline__ void attn_sample_item(int it, const KArgs& a, const bf16_t* QKV, bf16_t* OA, LAS unsigned char* lds, int wave, int lane) {
    const int db = it >> 2, t = it & 3;
    LAS float* pm = (LAS float*)lds;
    LAS float* pl = pm + 32;
    LAS float* pacc = pm + 64;
    if (wave < 6) {
        const int g = wave % 3, half = wave / 3, sh = 2 * g, wb = 128 << sh;
        const float* cache = (g == 0 ? a.in[2] : (g == 1 ? a.in[3] : a.in[4])) + (size_t)db * wb * 512;
        const int hh = lane >> 4, dd = 4 * (lane & 15);
        const size_t rowq = (size_t)(MP + db * 4 + t) * NQKV;
        const u32x2 qw = *(const u32x2*)(QKV + rowq + g * 256 + hh * 64 + dd);
        const float q0 = bflo(qw.x), q1 = bfhi(qw.x), q2 = bflo(qw.y), q3 = bfhi(qw.y);
        float m = -1e30f, l = 0.f, a0 = 0.f, a1 = 0.f, a2 = 0.f, a3 = 0.f;
        const int jn = t >> sh;
        int jlo = jn + 1, jhi = 65;
        if (half == 0) {
            for (int j = 0; j <= jn; ++j) {
                const size_t rk = (size_t)(MP + db * 4 + t - (j << sh)) * NQKV + g * 256 + hh * 64 + dd;
                const u32x2 kw = *(const u32x2*)(QKV + rk + 768), vw = *(const u32x2*)(QKV + rk + 1536);
                float d = q0 * bflo(kw.x) + q1 * bfhi(kw.x) + q2 * bflo(kw.y) + q3 * bfhi(kw.y);
                d += __shfl_xor(d, 1); d += __shfl_xor(d, 2); d += __shfl_xor(d, 4); d += __shfl_xor(d, 8);
                const float sc = d * SCALE, mn = fmaxf(m, sc), cr = __expf(m - mn), p = __expf(sc - mn);
                l = l * cr + p; a0 = a0 * cr + p * bflo(vw.x); a1 = a1 * cr + p * bfhi(vw.x); a2 = a2 * cr + p * bflo(vw.y); a3 = a3 * cr + p * bfhi(vw.y); m = mn;
            }
        } else { jlo = 65; jhi = 129; }
        for (int j0 = jlo; j0 < jhi; j0 += 8) {
            f32x4 kk[8], vv[8];
#pragma unroll
            for (int e = 0; e < 8; ++e) {
                const int j = min(j0 + e, jhi - 1);
                const float* p = cache + (size_t)(wb + t - (j << sh)) * 512 + hh * 64 + dd;
                kk[e] = *(const f32x4*)p; vv[e] = *(const f32x4*)(p + 256);
            }
#pragma unroll
            for (int e = 0; e < 8; ++e) {
                float d = q0 * kk[e][0] + q1 * kk[e][1] + q2 * kk[e][2] + q3 * kk[e][3];
                d += __shfl_xor(d, 1); d += __shfl_xor(d, 2); d += __shfl_xor(d, 4); d += __shfl_xor(d, 8);
                const float sc = (j0 + e < jhi) ? d * SCALE : -1e30f;
                const float mn = fmaxf(m, sc), cr = __expf(m - mn), p = __expf(sc - mn);
                l = l * cr + p; a0 = a0 * cr + p * vv[e][0]; a1 = a1 * cr + p * vv[e][1]; a2 = a2 * cr + p * vv[e][2]; a3 = a3 * cr + p * vv[e][3]; m = mn;
            }
        }
        if ((lane & 15) == 0) { pm[wave * 4 + hh] = m; pl[wave * 4 + hh] = l; }
        *(LAS f32x4*)(pacc + wave * 256 + hh * 64 + dd) = (f32x4){a0, a1, a2, a3};
    }
    __syncthreads();
    {
        const int tid = wave * 64 + lane;
        if (tid < 256) {
            const int hh = tid >> 6;
            float mm = -1e30f;
#pragma unroll
            for (int w = 0; w < 6; ++w) mm = fmaxf(mm, pm[w * 4 + hh]);
            float ll = 0.f, o = 0.f;
#pragma unroll
            for (int w = 0; w < 6; ++w) { const float e = __expf(pm[w * 4 + hh] - mm); ll += pl[w * 4 + hh] * e; o += pacc[w * 256 + tid] * e; }
            OA[(size_t)(MP + db * 4 + t) * 256 + tid] = (bf16_t)f2bf(o / ll);
        }
    }
    __syncthreads();
}

__device__ __forceinline__ void sgate_sample_item(int db, const KArgs& a, const bf16_t* Z, bf16_t* OB, int lane) {
    const float* lng = a.in[8]; const float* lnb = a.in[9]; const float* Wsp = a.in[10]; const float* bsp = a.in[11];
    float zn[4][8];
    const int gg = lane >> 4;
#pragma unroll
    for (int t = 0; t < 4; ++t) {
        const size_t row = (size_t)MP + db * 4 + t;
        const u32x4 raw = *(const u32x4*)(Z + row * 1024 + 512 + 8 * lane);
        float x[8] = {bflo(raw.x), bfhi(raw.x), bflo(raw.y), bfhi(raw.y), bflo(raw.z), bfhi(raw.z), bflo(raw.w), bfhi(raw.w)};
        float s = 0.f;
#pragma unroll
        for (int e = 0; e < 8; ++e) s += x[e];
        const float mean = wave_sum(s) * (1.f / 512.f); float s2 = 0.f;
#pragma unroll
        for (int e = 0; e < 8; ++e) { x[e] -= mean; s2 += x[e] * x[e]; }
        const float rstd = rsqrtf(wave_sum(s2) * (1.f / 512.f) + EPS);
#pragma unroll
        for (int e = 0; e < 8; ++e) zn[t][e] = x[e] * rstd * lng[8 * lane + e] + lnb[8 * lane + e];
        float* so = a.out + O_SG + (size_t)(db * 4 + t) * 512 + 8 * lane;
        *(f32x4*)so = (f32x4){zn[t][0], zn[t][1], zn[t][2], zn[t][3]}; *(f32x4*)(so + 4) = (f32x4){zn[t][4], zn[t][5], zn[t][6], zn[t][7]};
    }
#pragma unroll
    for (int t = 0; t < 4; ++t) {
        const size_t row = (size_t)MP + db * 4 + t;
        const float bb = bsp[gg * 128 + t];
        float mix[8];
#pragma unroll
        for (int e = 0; e < 8; ++e) mix[e] = bb;
#pragma unroll
        for (int s = 0; s <= t; ++s) { const float w = Wsp[((size_t)gg * 128 + t) * 128 + s];
#pragma unroll
            for (int e = 0; e < 8; ++e) mix[e] += w * zn[s][e]; }
        const u32x4 zw = *(const u32x4*)(Z + row * 1024 + 8 * lane);
        u32x4 w; w.x = cvt_pk_bf16(bflo(zw.x) * mix[0], bfhi(zw.x) * mix[1]); w.y = cvt_pk_bf16(bflo(zw.y) * mix[2], bfhi(zw.y) * mix[3]);
        w.z = cvt_pk_bf16(bflo(zw.z) * mix[4], bfhi(zw.z) * mix[5]); w.w = cvt_pk_bf16(bflo(zw.w) * mix[6], bfhi(zw.w) * mix[7]);
        *(u32x4*)(OB + row * 512 + 8 * lane) = w;
    }
}

#define XB_TMO      128
#define XB_XCNT(j)  (256  + 64 * (j))
#define XB_XSUB(j)  (1280 + 64 * (j))
#define XB_XGEN(j)  (2304 + 64 * (j))
#define XB_TOP      3328
#define XB_TOPGEN   3392
#define XCD_BAR_WORDS 3456
#define XB_SPIN_CAP (1u << 18)

__device__ __forceinline__ unsigned xb_ld(unsigned* p)              { return __hip_atomic_load(p, __ATOMIC_RELAXED, __HIP_MEMORY_SCOPE_AGENT); }
__device__ __forceinline__ unsigned xb_add(unsigned* p, unsigned v) { return __hip_atomic_fetch_add(p, v, __ATOMIC_RELAXED, __HIP_MEMORY_SCOPE_AGENT); }
__device__ __forceinline__ unsigned xb_xcc_id() { return (unsigned)__builtin_amdgcn_s_getreg((3 << 11) | 20) & 0xFu; }
#define XB_SPIN(cond, bar) do { unsigned _sp = 0; while (cond) { __builtin_amdgcn_s_sleep(1); \
    if ((++_sp & 255u) == 0u) { if (xb_ld(&(bar)[XB_TMO])) break; if (_sp > XB_SPIN_CAP) { atomicAdd(&(bar)[XB_TMO], 1u); break; } } } } while (0)

struct XcdBarrier {
    unsigned* bar; unsigned x;
    volatile LAS unsigned* st;
};

__device__ __forceinline__ XcdBarrier xcd_barrier_post(unsigned* bar, volatile LAS unsigned* st) {
    XcdBarrier b; b.bar = bar; b.x = xb_xcc_id(); b.st = st;
    if (threadIdx.x == 0) (void)xb_add(&bar[XB_XCNT(b.x)], 1u);
    return b;
}
__device__ __forceinline__ void xcd_barrier_complete(unsigned* bar, unsigned x, unsigned& nloc, unsigned& nx) {
    const unsigned G = gridDim.x * gridDim.y * gridDim.z;
    unsigned sum, cnt, mine, sp = 0u;
    for (;;) {
        sum = 0u; cnt = 0u; mine = 0u;
#pragma unroll
        for (unsigned j = 0; j < 16; ++j) { const unsigned c = xb_ld(&bar[XB_XCNT(j)]); sum += c; cnt += (c > 0u) ? 1u : 0u; mine = (j == x) ? c : mine; }
        if (sum == G) break;
        __builtin_amdgcn_s_sleep(1);
        if ((++sp & 255u) == 0u) { if (xb_ld(&bar[XB_TMO])) break; if (sp > XB_SPIN_CAP) { atomicAdd(&bar[XB_TMO], 1u); break; } }
    }
    nloc = mine > 0u ? mine : 1u; nx = cnt > 0u ? cnt : 1u;
}

__device__ __forceinline__ void xcd_barrier(const XcdBarrier& b) {
    asm volatile("s_waitcnt vmcnt(0)" ::: "memory");
    __syncthreads();
    if (threadIdx.x == 0) {
        unsigned* bar = b.bar;
        __builtin_amdgcn_s_waitcnt(0);
        unsigned nloc = b.st[0], nx = b.st[1];
        if (nloc == 0u) { xcd_barrier_complete(bar, b.x, nloc, nx); b.st[0] = nloc; b.st[1] = nx; }
        const unsigned old = xb_add(&bar[XB_XSUB(b.x)], 1u);
        const unsigned gen = old / nloc;
        if (old + 1u == (gen + 1u) * nloc) {
            __builtin_amdgcn_fence(__ATOMIC_RELEASE, "agent");
            asm volatile("s_waitcnt vmcnt(0)" ::: "memory");
            const unsigned og = xb_add(&bar[XB_TOP], 1u);
            const unsigned tg = og / nx;
            if (og + 1u == (tg + 1u) * nx) xb_add(&bar[XB_TOPGEN], 1u);
            else XB_SPIN(xb_ld(&bar[XB_TOPGEN]) == tg, bar);
            __builtin_amdgcn_fence(__ATOMIC_ACQUIRE, "agent");
            xb_add(&bar[XB_XGEN(b.x)], 1u);
            asm volatile("s_waitcnt vmcnt(0)" ::: "memory");
        } else {
            XB_SPIN(xb_ld(&bar[XB_XGEN(b.x)]) == gen, bar);
            __builtin_amdgcn_fence(__ATOMIC_ACQUIRE, "agent");
            asm volatile("s_waitcnt vmcnt(0)" ::: "memory");
        }
    }
    __syncthreads();
}

#ifndef REP_A
#define REP_A 1
#define REP_B 1
#define REP_C 1
#define REP_P1 1
#define REP_P5 1
#define REP_SYNC 0
#endif
#ifndef PHM
#define PHM 0x1fff
#endif
__global__ void __launch_bounds__(512, 2) fwd_megakernel(KArgs a) {
    extern __shared__ __attribute__((aligned(16))) unsigned char lds_raw[];
    cg::grid_group grid = cg::this_grid();
    LAS unsigned char* lds = (LAS unsigned char*)lds_raw;
    const int G = gridDim.x, bid = blockIdx.x, NGW = G * 8;
#define FRESH_IDS int tid_ = threadIdx.x; asm volatile("" : "+v"(tid_)); const int lane = tid_ & 63, wave = __builtin_amdgcn_readfirstlane(tid_ >> 6), gw = bid * 8 + wave; (void)gw; (void)lane;
    unsigned char* ws = a.ws;
    volatile LAS unsigned* bst = (volatile LAS unsigned*)(lds + 131072 + 64);
    if (threadIdx.x < 2) bst[threadIdx.x] = 0u;
    __syncthreads();
    const XcdBarrier xbar = xcd_barrier_post((unsigned*)(ws + WS_BAR), bst);
#define SEAM() xcd_barrier(xbar)
    bf16_t* XN = (bf16_t*)(ws + WS_XN); bf16_t* QKV = (bf16_t*)(ws + WS_QKV); bf16_t* VT = (bf16_t*)(ws + WS_VT); bf16_t* Zb = (bf16_t*)(ws + WS_Z);
    bf16_t* Gb = (bf16_t*)(ws + WS_G); bf16_t* OA = (bf16_t*)(ws + WS_OA); bf16_t* OB = (bf16_t*)(ws + WS_OB); float* T = (float*)(ws + WS_T);
    bf16_t* MG = (bf16_t*)(ws + WS_MG); bf16_t* U = (bf16_t*)(ws + WS_U); float* rss = (float*)(ws + WS_RSS);

    if (PHM & 1) { FRESH_IDS p0_prologue(a, lds, wave, lane, gw, NGW); }
    grid.sync();
    if (PHM & 2) {
        pg8::Gemm g{XN, (const bf16_t*)(ws + WS_WIN), MT, NIN, DM}; pg8::StaticOrder S; S.init(MT, NIN, G, bid);
        EpiIn E{QKV, VT, Zb, Gb, a.out, a.in[7]};
        pg8::gemm_phase<EpiIn, pg8::StaticOrder, true, true>(lds, g, S, E);
#if REP_P1 > 1
        pg8::gemm_phase<EpiIn, pg8::StaticOrder, true, true>(lds, g, S, E);
#endif
    }
    SEAM();
    if (PHM & 4) { FRESH_IDS for (int u = bid; u < 256; u += G) attn_prompt_unit(u, QKV, VT, OA, lds, wave, lane); }
#if REP_A > 1
    if (PHM & 4) { FRESH_IDS for (int u = bid; u < 256; u += G) attn_prompt_unit(u, QKV, VT, OA, lds, wave, lane); }
#endif
    if (PHM & 8) { FRESH_IDS for (int u = bid; u < 512; u += G) sgate_prompt_unit(u, Zb, a.in[8], a.in[9], a.in[10], a.in[11], OB, lds, wave, lane); }
#if REP_B > 1
    if (PHM & 8) { FRESH_IDS for (int u = bid; u < 512; u += G) sgate_prompt_unit(u, Zb, a.in[8], a.in[9], a.in[10], a.in[11], OB, lds, wave, lane); }
#endif
    if (PHM & 16) { FRESH_IDS for (int it = bid; it < MS; it += G) attn_sample_item(it, a, QKV, OA, lds, wave, lane); }
#if REP_C > 1
    if (PHM & 16) { FRESH_IDS for (int it = bid; it < MS; it += G) attn_sample_item(it, a, QKV, OA, lds, wave, lane); }
#endif
    if (PHM & 32) { FRESH_IDS for (int db = gw; db < 128; db += NGW) sgate_sample_item(db, a, Zb, OB, lane); }
    SEAM();
    if (PHM & 64) {
        pg8::Gemm g{OA, (const bf16_t*)(ws + WS_WAO), MT, DM, 256}; pg8::StaticOrder S; S.init(MT, DM, G, bid);
        EpiGateA E{Gb, T};
        pg8::gemm_phase<EpiGateA, pg8::StaticOrder, true, true>(lds, g, S, E);
    }
    if (PHM & 128) {
        pg8::Gemm g{OB, (const bf16_t*)(ws + WS_WBO), MT, DM, 512}; pg8::StaticOrder S; S.init(MT, DM, G, bid);
        EpiGateB E{Gb, T, MG};
        pg8::gemm_phase<EpiGateB, pg8::StaticOrder, true, true>(lds, g, S, E);
    }
    SEAM();
    if (PHM & 256) {
        pg8::Gemm g{MG, (const bf16_t*)(ws + WS_WOUT), MT, DM, DM}; pg8::StaticOrder S; S.init(MT, DM, G, bid);
        EpiSS E{T, rss};
        pg8::gemm_phase<EpiSS, pg8::StaticOrder, true, true>(lds, g, S, E);
    }
    SEAM();
    if (PHM & 512) {
        FRESH_IDS
        const float* g1 = a.in[15]; const float* g2 = a.in[16];
        for (int row = gw; row < MT; row += NGW) {
            const f32x4* xr = (const f32x4*)xrow_ptr(a, row) + lane; const f32x4* tr = (const f32x4*)(T + (size_t)row * DM) + lane;
            const float r1 = rsqrtf(rss[row] * (1.f / DM) + EPS);
            f32x4 v[4]; float s = 0.f;
#pragma unroll
            for (int j = 0; j < 4; ++j) { const f32x4 x = xr[64 * j], t = tr[64 * j], g = ((const f32x4*)g1)[lane + 64 * j];
                v[j] = x + t * r1 * g; s += (v[j][0] * v[j][0] + v[j][1] * v[j][1]) + (v[j][2] * v[j][2] + v[j][3] * v[j][3]); }
            const float r2 = rsqrtf(wave_sum(s) * (1.f / DM) + EPS);
            f32x4* yo = (f32x4*)(a.out + O_Y + (size_t)row * DM) + lane; u32x2* ho = (u32x2*)(XN + (size_t)row * DM) + lane;
#pragma unroll
            for (int j = 0; j < 4; ++j) { const f32x4 g = ((const f32x4*)g2)[lane + 64 * j]; yo[64 * j] = v[j];
                u32x2 w; w.x = pk2(v[j][0] * r2 * g[0], v[j][1] * r2 * g[1]); w.y = pk2(v[j][2] * r2 * g[2], v[j][3] * r2 * g[3]); ho[64 * j] = w; }
        }
    }
    SEAM();
    if (PHM & 1024) {
        pg8::Gemm g{XN, (const bf16_t*)(ws + WS_WUP), MT, FF, DM}; pg8::StaticOrder S; S.init(MT, FF, G, bid);
        EpiUp E{U};
        pg8::gemm_phase<EpiUp, pg8::StaticOrder, true, true>(lds, g, S, E);
#if REP_P5 > 1
        pg8::gemm_phase<EpiUp, pg8::StaticOrder, true, true>(lds, g, S, E);
#endif
    }
    SEAM();
    if (PHM & 2048) {
        pg8::Gemm g{U, (const bf16_t*)(ws + WS_WDN), MT, DM, FF}; pg8::StaticOrder S; S.init(MT, DM, G, bid);
        EpiSS E{T, rss + MT};
        pg8::gemm_phase<EpiSS, pg8::StaticOrder, true, true>(lds, g, S, E);
    }
    SEAM();
#if REP_SYNC > 0
    for (int i = 0; i < REP_SYNC; ++i) grid.sync();
#endif
    if (PHM & 4096) {
        FRESH_IDS
        const float* g3 = a.in[19];
        for (int row = gw; row < MT; row += NGW) {
            const f32x4* tr = (const f32x4*)(T + (size_t)row * DM) + lane; f32x4* yo = (f32x4*)(a.out + O_Y + (size_t)row * DM) + lane;
            const float r3 = rsqrtf(rss[MT + row] * (1.f / DM) + EPS);
#pragma unroll
            for (int j = 0; j < 4; ++j) { const f32x4 g = ((const f32x4*)g3)[lane + 64 * j]; yo[64 * j] = yo[64 * j] + tr[64 * j] * r3 * g; }
        }
    }
}

extern "C" void kernel_launch(void* const* d_in, const int* in_sizes, int n_in, void* d_out, int out_size, void* d_ws, size_t ws_size, hipStream_t stream) {
    static int grid_blocks = 0;
    if (grid_blocks == 0) {
        if (n_in != 20 || ws_size < WS_END) { fprintf(stderr, "kernel_launch: unexpected n_in %d / ws_size %zu (need %zu)\n", n_in, ws_size, (size_t)WS_END); grid_blocks = -1; return; }
        int dev = 0, cus = 0, per_cu = 0;
        (void)hipGetDevice(&dev);
        (void)hipDeviceGetAttribute(&cus, hipDeviceAttributeMultiprocessorCount, dev);
        (void)hipFuncSetAttribute((const void*)fwd_megakernel, hipFuncAttributeMaxDynamicSharedMemorySize, LDS_BYTES);
        (void)hipOccupancyMaxActiveBlocksPerMultiprocessor(&per_cu, (const void*)fwd_megakernel, 512, LDS_BYTES);
        if (per_cu < 1) { fprintf(stderr, "kernel_launch: occupancy query reports %d blocks per CU\n", per_cu); per_cu = 1; }
        if (per_cu > 1) per_cu = 1;
        grid_blocks = cus * per_cu;
    }
    if (grid_blocks < 0) return;
    if (hipMemsetAsync((char*)d_ws + WS_BAR, 0, 16384, stream) != hipSuccess) { fprintf(stderr, "kernel_launch: hipMemsetAsync failed\n"); return; }
    KArgs a{};
    for (int i = 0; i < 20; ++i) a.in[i] = (const float*)d_in[i];
    a.out = (float*)d_out; a.ws = (unsigned char*)d_ws;
    void* kargs[] = {&a};
    hipError_t e = hipLaunchCooperativeKernel((const void*)fwd_megakernel, dim3(grid_blocks), dim3(512), kargs, LDS_BYTES, stream);
    if (e != hipSuccess) fprintf(stderr, "cooperative launch failed: %s (grid %d)\n", hipGetErrorString(e), grid_blocks);
}
```

```cpp
#include <hip/hip_runtime.h>
#include <hip/hip_cooperative_groups.h>
#include <cstdio>
#include <cstdint>
namespace cg = cooperative_groups;
namespace pg8 {
#define PG8_LAS __attribute__((address_space(3)))
typedef unsigned short bf16_t;
typedef short bf16x8 __attribute__((ext_vector_type(8)));
typedef float f32x4 __attribute__((ext_vector_type(4)));
typedef unsigned u32x4 __attribute__((ext_vector_type(4)));
constexpr int BM = 256, BK = 64, HALF = 128, HTB = HALF * BK * 2  , STAGE_BYTES = 8 * HTB, NXCD = 8, WGM = 8;

__host__ __device__ __forceinline__ int lds_byte(int r, int c) { const int st = (r >> 4) * 2 + (c >> 5), rr = r & 15, cc = c & 31, ob = rr * 64 + cc * 2; return st * 1024 + (ob ^ (((ob >> 9) & 1) << 5)); }
__host__ __device__ __forceinline__ void stage_rc(int b, int& R, int& C) { const int st = b / 1024, sb = b % 1024, swz = sb ^ (((sb >> 9) & 1) << 5); R = (st >> 1) * 16 + swz / 64; C = (st & 1) * 32 + (swz % 64) / 2; }
__host__ __device__ __forceinline__ int perm32(int rho) { const int n = rho >> 4, i = rho & 15; return 8 * (i >> 2) + 4 * n + (i & 3); }

struct Unit { int pm, pn, ko, ks; };
struct Gemm { const bf16_t* A; const bf16_t* Bt; int M, N, K, lda, ldb; };

struct StaticOrder {
    int nM, nN, nwg, G, c;
    __host__ __device__ void init(int M, int N, int G_, int c_) { nM = M / BM; nN = N / BM; nwg = nM * nN; G = G_; c = c_; }
    __host__ __device__ bool next(int i, Unit& u) const {
        const long L = (long)i * G + c; if (L >= nwg) return false;
        int wgid = (int)L; { const int q = nwg / NXCD, r = nwg % NXCD, xcd = wgid % NXCD, off = wgid / NXCD; wgid = (xcd < r ? xcd * (q + 1) : r * (q + 1) + (xcd - r) * q) + off; }
        const int nig = WGM * nN, gid = wgid / nig, fm = gid * WGM, gsz = (nM - fm) < WGM ? (nM - fm) : WGM;
        u.pm = fm + ((wgid % nig) % gsz); u.pn = (wgid % nig) / gsz; u.ko = 0; u.ks = 0; return true;
    }
    __device__ __forceinline__ void a_ready(const Unit&) const {}
    __device__ __forceinline__ void done(const Unit&) const {}
};
__device__ __forceinline__ unsigned cvt_pk_bf16(float lo, float hi) { unsigned r; asm volatile("v_cvt_pk_bf16_f32 %0, %1, %2" : "=v"(r) : "v"(lo), "v"(hi)); return r; }
typedef float f32x2 __attribute__((ext_vector_type(2)));
template <class Epi, class Sched, bool ALIGN_EPI = false, bool SP2 = false>
__device__ __forceinline__ void gemm_phase(PG8_LAS unsigned char* lds, const Gemm g, const Sched& S, const Epi& E) {
    int tid_ = threadIdx.x; asm volatile("" : "+v"(tid_));
    const int tid = tid_, wid = __builtin_amdgcn_readfirstlane(tid >> 6), lane = tid & 63, wr = wid >> 2, wc = wid & 3, fr = lane & 15, fq = lane >> 4;
    const int K = g.K, nt = K / BK;
    unsigned voffA[2], voffB[2];
#pragma unroll
    for (int i = 0; i < 2; ++i) { int R, C; stage_rc(tid * 16 + i * 8192, R, C); const int Rb = Epi::PERM ? ((R & ~31) + perm32(R & 31)) : R;
        voffA[i] = (unsigned)(R * g.lda + C) * 2u; voffB[i] = (unsigned)(Rb * g.ldb + C) * 2u; }
    const size_t kstep = (size_t)(BK * 2);
    const size_t hstepA = (size_t)HALF * g.lda * 2, hstepB = (size_t)HALF * g.ldb * 2;
    const size_t tstepA = 2 * hstepA, tstepB = 2 * hstepB;
    const unsigned ldsw = (unsigned)wid * 1024u;
    const int aoff = lds_byte(wr * 64 + fr, fq * 8), boff = lds_byte(wc * 32 + fr, fq * 8);
#define PG8_SA(b, h) (((b) * 2 + (h)) * HTB)
#define PG8_SB(b, h) ((4 + (b) * 2 + (h)) * HTB)
#define PG8_STAGE(bufoff, gbase, voff) do { _Pragma("unroll") for (int _i = 0; _i < 2; ++_i) \
        __builtin_amdgcn_global_load_lds((const unsigned*)((const char*)(gbase) + (voff)[_i]), (PG8_LAS unsigned*)(lds + (bufoff) + ldsw + _i * 8192), 16, 0, 0); } while (0)
#define PG8_LDA(dst, b, h) do { _Pragma("unroll") for (int m = 0; m < 4; ++m) _Pragma("unroll") for (int k = 0; k < 2; ++k) dst[m][k] = *(const PG8_LAS bf16x8*)(lds + PG8_SA(b, h) + aoff + m * 2048 + k * 1024); } while (0)
#define PG8_LDB(dst, b, h) do { _Pragma("unroll") for (int n = 0; n < 2; ++n) _Pragma("unroll") for (int k = 0; k < 2; ++k) dst[n][k] = *(const PG8_LAS bf16x8*)(lds + PG8_SB(b, h) + boff + n * 2048 + k * 1024); } while (0)
#define PG8_MMA(ai, bj, At, Bt) do { __builtin_amdgcn_s_setprio(1); _Pragma("unroll") for (int m = 0; m < 4; ++m) _Pragma("unroll") for (int n = 0; n < 2; ++n) _Pragma("unroll") for (int k = 0; k < 2; ++k) \
        acc[ai][bj][m][n] = __builtin_amdgcn_mfma_f32_16x16x32_bf16(Bt[n][k], At[m][k], acc[ai][bj][m][n], 0, 0, 0); __builtin_amdgcn_s_setprio(0); } while (0)
#define PG8_WAIT_V(n) asm volatile("s_waitcnt vmcnt(" #n ")" ::: "memory")
#define PG8_WAIT_L(n) asm volatile("s_waitcnt lgkmcnt(" #n ")" ::: "memory")
#define PG8_BAR __builtin_amdgcn_s_barrier()
#define PG8_SCHED __builtin_amdgcn_sched_barrier(0)
    Unit cur, nxt; int ui = 0;
    if (!S.next(0, cur)) return;
    f32x4 acc[2][2][4][2];
#pragma unroll
    for (int a = 0; a < 2; ++a)
#pragma unroll
        for (int b = 0; b < 2; ++b)
#pragma unroll
            for (int m = 0; m < 4; ++m)
#pragma unroll
                for (int n = 0; n < 2; ++n) acc[a][b][m][n] = (f32x4){0.f, 0.f, 0.f, 0.f};
    bf16x8 At[4][2], B0[2][2], B1[2][2];
    const char* cA = (const char*)g.A + (size_t)cur.pm * tstepA + (size_t)cur.ko * 2; const char* cB = (const char*)g.Bt + (size_t)cur.pn * tstepB + (size_t)cur.ko * 2;
    S.a_ready(cur);
    if constexpr (SP2) {
        PG8_STAGE(PG8_SB(0, 0), cB, voffB); PG8_STAGE(PG8_SB(0, 1), cB + hstepB, voffB); PG8_STAGE(PG8_SA(0, 0), cA, voffA); PG8_STAGE(PG8_SA(0, 1), cA + hstepA, voffA);
        if (wr == 1) PG8_BAR;
        PG8_WAIT_V(2); PG8_BAR;
        PG8_STAGE(PG8_SB(1, 0), cB + kstep, voffB); PG8_STAGE(PG8_SA(1, 0), cA + kstep, voffA); PG8_STAGE(PG8_SB(1, 1), cB + hstepB + kstep, voffB);
        PG8_WAIT_V(6); PG8_BAR;
    } else {
        PG8_STAGE(PG8_SB(0, 0), cB, voffB); PG8_STAGE(PG8_SA(0, 0), cA, voffA); PG8_STAGE(PG8_SB(0, 1), cB + hstepB, voffB); PG8_STAGE(PG8_SA(0, 1), cA + hstepA, voffA);
        if (wr == 1) PG8_BAR;
        PG8_WAIT_V(4); PG8_BAR;
        PG8_STAGE(PG8_SB(1, 0), cB + kstep, voffB); PG8_STAGE(PG8_SA(1, 0), cA + kstep, voffA); PG8_STAGE(PG8_SB(1, 1), cB + hstepB + kstep, voffB);
        PG8_WAIT_V(6); PG8_BAR;
    }
    for (;;) {
        const bool has_next = S.next(ui + 1, nxt);
        const char* nA = has_next ? (const char*)g.A + (size_t)nxt.pm * tstepA + (size_t)nxt.ko * 2 : cA; const char* nB = has_next ? (const char*)g.Bt + (size_t)nxt.pn * tstepB + (size_t)nxt.ko * 2 : cB;
        for (int t = 0; t < nt; t += 2) {
            const bool last = (t == nt - 2);
            const char* a1 = cA + (size_t)(t + 1) * kstep;
            const char* a2 = last ? nA : cA + (size_t)(t + 2) * kstep; const char* b2 = last ? nB : cB + (size_t)(t + 2) * kstep;
            const char* a3 = a2 + kstep; const char* b3 = b2 + kstep;
            if (last && has_next) S.a_ready(nxt);
            if constexpr (SP2) {
            PG8_LDB(B0, 0, 0); PG8_LDB(B1, 0, 1); PG8_SCHED; PG8_LDA(At, 0, 0); PG8_STAGE(PG8_SA(1, 1), a1 + hstepA, voffA);
            PG8_WAIT_V(8); PG8_WAIT_L(0); PG8_BAR; PG8_MMA(0, 0, At, B0); PG8_MMA(0, 1, At, B1); PG8_BAR; PG8_SCHED;
            PG8_LDA(At, 0, 1); PG8_STAGE(PG8_SB(0, 0), b2, voffB); PG8_STAGE(PG8_SB(0, 1), b2 + hstepB, voffB); PG8_STAGE(PG8_SA(0, 0), a2, voffA);
            PG8_WAIT_V(8); PG8_WAIT_L(0); PG8_BAR; PG8_MMA(1, 0, At, B0); PG8_MMA(1, 1, At, B1); PG8_BAR; PG8_SCHED;
            PG8_LDB(B0, 1, 0); PG8_LDB(B1, 1, 1); PG8_SCHED; PG8_LDA(At, 1, 0); PG8_STAGE(PG8_SA(0, 1), a2 + hstepA, voffA);
            PG8_WAIT_V(8); PG8_WAIT_L(0); PG8_BAR; PG8_MMA(0, 0, At, B0); PG8_MMA(0, 1, At, B1); PG8_BAR; PG8_SCHED;
            PG8_LDA(At, 1, 1); PG8_STAGE(PG8_SB(1, 0), b3, voffB); PG8_STAGE(PG8_SB(1, 1), b3 + hstepB, voffB); PG8_STAGE(PG8_SA(1, 0), a3, voffA);
            PG8_WAIT_V(8); PG8_WAIT_L(0); PG8_BAR; PG8_MMA(1, 0, At, B0); PG8_MMA(1, 1, At, B1); PG8_BAR; PG8_SCHED;
            } else {
            PG8_LDB(B0, 0, 0); PG8_SCHED; PG8_LDA(At, 0, 0); PG8_STAGE(PG8_SA(1, 1), a1 + hstepA, voffA);
            PG8_WAIT_L(8); PG8_BAR; PG8_WAIT_L(0); PG8_MMA(0, 0, At, B0); PG8_BAR; PG8_SCHED;
            PG8_LDB(B1, 0, 1); PG8_STAGE(PG8_SB(0, 0), b2, voffB);
            PG8_BAR; PG8_WAIT_L(0); PG8_MMA(0, 1, At, B1); PG8_BAR;
            PG8_LDA(At, 0, 1); PG8_STAGE(PG8_SA(0, 0), a2, voffA);
            PG8_BAR; PG8_WAIT_L(0); PG8_MMA(1, 0, At, B0); PG8_BAR; PG8_SCHED;
            PG8_STAGE(PG8_SB(0, 1), b2 + hstepB, voffB);
            PG8_WAIT_V(6); PG8_BAR; PG8_MMA(1, 1, At, B1); PG8_BAR;
            PG8_LDB(B0, 1, 0); PG8_SCHED; PG8_LDA(At, 1, 0); PG8_STAGE(PG8_SA(0, 1), a2 + hstepA, voffA);
            PG8_WAIT_L(8); PG8_BAR; PG8_WAIT_L(0); PG8_MMA(0, 0, At, B0); PG8_BAR; PG8_SCHED;
            PG8_LDB(B1, 1, 1); PG8_STAGE(PG8_SB(1, 0), b3, voffB);
            PG8_BAR; PG8_WAIT_L(0); PG8_MMA(0, 1, At, B1); PG8_BAR;
            PG8_LDA(At, 1, 1); PG8_STAGE(PG8_SA(1, 0), a3, voffA);
            PG8_BAR; PG8_WAIT_L(0); PG8_MMA(1, 0, At, B0); PG8_BAR; PG8_SCHED;
            PG8_STAGE(PG8_SB(1, 1), b3 + hstepB, voffB);
            PG8_WAIT_V(6); PG8_BAR; PG8_MMA(1, 1, At, B1); PG8_BAR;
            }
        }
        if constexpr (ALIGN_EPI) { if (wr == 0) PG8_BAR; }
        if constexpr (!Epi::AFTER_DRAIN) { E(acc, cur, wr, wc, fr, fq); S.done(cur); }
        if (!has_next) break;
#pragma unroll
        for (int a = 0; a < 2; ++a)
#pragma unroll
            for (int b = 0; b < 2; ++b)
#pragma unroll
                for (int m = 0; m < 4; ++m)
#pragma unroll
                    for (int n = 0; n < 2; ++n) acc[a][b][m][n] = (f32x4){0.f, 0.f, 0.f, 0.f};
        cur = nxt; cA = nA; cB = nB; ++ui;
        if constexpr (ALIGN_EPI) { if (wr == 1) PG8_BAR; }
    }
    PG8_WAIT_V(0);
    if constexpr (!ALIGN_EPI) { if (wr == 0) PG8_BAR; }
    PG8_BAR;
    if constexpr (Epi::AFTER_DRAIN) { E.fused(acc, cur, wr, wc, fr, fq, lds, wid, lane); S.done(cur); }
#undef PG8_SA
#undef PG8_SB
#undef PG8_STAGE
#undef PG8_LDA
#undef PG8_LDB
#undef PG8_MMA
#undef PG8_WAIT_V
#undef PG8_WAIT_L
#undef PG8_BAR
#undef PG8_SCHED
}
}

using pg8::bf16_t; using pg8::bf16x8; using pg8::f32x4; using pg8::u32x4; using pg8::Unit; using pg8::cvt_pk_bf16;
#define LAS __attribute__((address_space(3)))
typedef unsigned long long u64;
typedef unsigned u32x2 __attribute__((ext_vector_type(2)));

constexpr int MP = 16384, MS = 512, MT = MP + MS;
constexpr int DM = 1024, NIN = 5376, FF = 4096, NQKV = 2304;
constexpr float EPS = 1e-6f, SCALE = 0.125f, LOG2E = 1.4426950408889634f;
constexpr size_t O_Y = 0, O_KVP0 = 17301504, O_KVP1 = 17825792, O_KVP2 = 19922944, O_KVS0 = 28311552, O_KVS1 = 28573696, O_KVS2 = 28835840, O_SG = 29097984;
constexpr size_t al(size_t x) { return (x + 4095) & ~(size_t)4095; }
constexpr size_t WS_BAR   = 0;
constexpr size_t WS_RSS   = 16384;
constexpr size_t WS_WIN   = al(WS_RSS + 2 * MT * 4);
constexpr size_t WS_WAO   = al(WS_WIN + (size_t)NIN * DM * 2);
constexpr size_t WS_WBO   = al(WS_WAO + (size_t)DM * 256 * 2);
constexpr size_t WS_WOUT  = al(WS_WBO + (size_t)DM * 512 * 2);
constexpr size_t WS_WUP   = al(WS_WOUT + (size_t)DM * DM * 2);
constexpr size_t WS_WDN   = al(WS_WUP + (size_t)FF * DM * 2);
constexpr size_t WS_XN    = al(WS_WDN + (size_t)DM * FF * 2);
constexpr size_t WS_QKV   = al(WS_XN + (size_t)MT * DM * 2);
constexpr size_t WS_VT    = al(WS_QKV + (size_t)MT * NQKV * 2);
constexpr size_t WS_Z     = al(WS_VT + (size_t)8 * 3 * 4 * 64 * 2048 * 2);
constexpr size_t WS_G     = al(WS_Z + (size_t)MT * 1024 * 2);
constexpr size_t WS_OA    = al(WS_G + (size_t)MT * 2048 * 2);
constexpr size_t WS_OB    = al(WS_OA + (size_t)MT * 256 * 2);
constexpr size_t WS_T     = al(WS_OB + (size_t)MT * 512 * 2);
constexpr size_t WS_MG    = al(WS_T + (size_t)MT * DM * 4);
constexpr size_t WS_U     = al(WS_MG + (size_t)MT * DM * 2);
constexpr size_t WS_TP    = al(WS_U + (size_t)MT * FF * 2);
constexpr size_t WS_END   = al(WS_TP + (size_t)16 * MS * DM * 4);
constexpr int LDS_BYTES = 147456;

__device__ __forceinline__ float bf2f(unsigned short h) { return __builtin_bit_cast(float, (unsigned)h << 16); }
__device__ __forceinline__ float bflo(unsigned w) { return __builtin_bit_cast(float, w << 16); }
__device__ __forceinline__ float bfhi(unsigned w) { return __builtin_bit_cast(float, w & 0xffff0000u); }
__device__ __forceinline__ unsigned f2bf(float f) { unsigned u = __builtin_bit_cast(unsigned, f); return (u + 0x7fffu + ((u >> 16) & 1u)) >> 16; }
__device__ __forceinline__ unsigned pk2(float lo, float hi) { return f2bf(lo) | (f2bf(hi) << 16); }
__device__ __forceinline__ float wave_sum(float v) {
#pragma unroll
    for (int o = 1; o < 64; o <<= 1) v += __shfl_xor(v, o);
    return v;
}
__device__ __forceinline__ f32x4 mfma16(bf16x8 a, bf16x8 b, f32x4 c) { return __builtin_amdgcn_mfma_f32_16x16x32_bf16(a, b, c, 0, 0, 0); }

#define EPI_LOOP for (int ai = 0; ai < 2; ++ai) _Pragma("unroll") for (int m = 0; m < 4; ++m) _Pragma("unroll") for (int bj = 0; bj < 2; ++bj)

struct EpiIn {
    static constexpr bool PERM = true, AFTER_DRAIN = false;
    bf16_t* QKV; bf16_t* VT; bf16_t* Z; bf16_t* G; float* out; const float* bgate;
    __device__ __forceinline__ void operator()(const f32x4 (&acc)[2][2][4][2], const Unit& u, int wr, int wc, int fr, int fq) const {
        const int pn = u.pn, row0 = u.pm * 256 + wr * 64 + fr, cl0 = wc * 32 + 8 * fq;
        if (pn < 9) {
            const int g = pn % 3, kvsel = (pn >= 6) ? 1 : 0, sh = 2 * g;
#pragma unroll
            EPI_LOOP {
                const int row = row0 + ai * 128 + m * 16, cl = cl0 + bj * 128;
                const f32x4 v0 = acc[ai][bj][m][0], v1 = acc[ai][bj][m][1];
                u32x4 w; w.x = cvt_pk_bf16(v0[0], v0[1]); w.y = cvt_pk_bf16(v0[2], v0[3]); w.z = cvt_pk_bf16(v1[0], v1[1]); w.w = cvt_pk_bf16(v1[2], v1[3]);
                *(u32x4*)(QKV + (size_t)row * NQKV + pn * 256 + cl) = w;
                if (pn >= 3) {
                    float* dst = nullptr;
                    if (row < MP) {
                        const int b = row >> 11, s = row & 2047;
                        if (g == 0) { if (s >= 1920) dst = out + O_KVP0 + ((size_t)(b * 128 + s - 1920) * 2 + kvsel) * 256; }
                        else if (g == 1) { if (s >= 1536) dst = out + O_KVP1 + ((size_t)(b * 512 + s - 1536) * 2 + kvsel) * 256; }
                        else dst = out + O_KVP2 + ((size_t)(b * 2048 + s) * 2 + kvsel) * 256;
                        if (pn >= 6) {
                            const int r = s & ((1 << sh) - 1), mm = s >> sh, L = 2048 >> sh;
                            bf16_t* vt = VT + ((size_t)((b * 3 + g) * 256 + cl)) * 2048 + r * L + mm;
                            vt[0 * 2048] = (bf16_t)(w.x & 0xffff); vt[1 * 2048] = (bf16_t)(w.x >> 16); vt[2 * 2048] = (bf16_t)(w.y & 0xffff); vt[3 * 2048] = (bf16_t)(w.y >> 16);
                            vt[4 * 2048] = (bf16_t)(w.z & 0xffff); vt[5 * 2048] = (bf16_t)(w.z >> 16); vt[6 * 2048] = (bf16_t)(w.w & 0xffff); vt[7 * 2048] = (bf16_t)(w.w >> 16);
                        }
                    } else {
                        const int rs = row - MP;
                        dst = out + (g == 0 ? O_KVS0 : (g == 1 ? O_KVS1 : O_KVS2)) + ((size_t)rs * 2 + kvsel) * 256;
                    }
                    if (dst) { *(f32x4*)(dst + cl) = v0; *(f32x4*)(dst + cl + 4) = v1; }
                }
            }
        } else if (pn < 13) {
#pragma unroll
            EPI_LOOP {
                const int row = row0 + ai * 128 + m * 16, cl = cl0 + bj * 128;
                f32x4 v0 = acc[ai][bj][m][0], v1 = acc[ai][bj][m][1];
#pragma unroll
                for (int e = 0; e < 4; ++e) { v0[e] = 0.5f * v0[e] * (1.f + erff(v0[e] * 0.70710678118654752f)); v1[e] = 0.5f * v1[e] * (1.f + erff(v1[e] * 0.70710678118654752f)); }
                u32x4 w; w.x = cvt_pk_bf16(v0[0], v0[1]); w.y = cvt_pk_bf16(v0[2], v0[3]); w.z = cvt_pk_bf16(v1[0], v1[1]); w.w = cvt_pk_bf16(v1[2], v1[3]);
                *(u32x4*)(Z + (size_t)row * 1024 + (pn - 9) * 256 + cl) = w;
            }
        } else {
#pragma unroll
            EPI_LOOP {
                const int row = row0 + ai * 128 + m * 16, cg_ = (pn - 13) * 256 + cl0 + bj * 128;
                const f32x4 b0 = *(const f32x4*)(bgate + cg_), b1 = *(const f32x4*)(bgate + cg_ + 4);
                f32x4 v0 = acc[ai][bj][m][0] + b0, v1 = acc[ai][bj][m][1] + b1;
#pragma unroll
                for (int e = 0; e < 4; ++e) { v0[e] = 1.f / (1.f + __expf(-v0[e])); v1[e] = 1.f / (1.f + __expf(-v1[e])); }
                u32x4 w; w.x = cvt_pk_bf16(v0[0], v0[1]); w.y = cvt_pk_bf16(v0[2], v0[3]); w.z = cvt_pk_bf16(v1[0], v1[1]); w.w = cvt_pk_bf16(v1[2], v1[3]);
                *(u32x4*)(G + (size_t)row * 2048 + cg_) = w;
            }
        }
    }
};

struct EpiGateA {
    static constexpr bool PERM = true, AFTER_DRAIN = false;
    const bf16_t* G; float* T;
    __device__ __forceinline__ void operator()(const f32x4 (&acc)[2][2][4][2], const Unit& u, int wr, int wc, int fr, int fq) const {
        const int row0 = u.pm * 256 + wr * 64 + fr, c0 = u.pn * 256 + wc * 32 + 8 * fq;
#pragma unroll
        EPI_LOOP {
            const int row = row0 + ai * 128 + m * 16, col = c0 + bj * 128;
            const u32x4 gw = *(const u32x4*)(G + (size_t)row * 2048 + col);
            f32x4 v0 = acc[ai][bj][m][0], v1 = acc[ai][bj][m][1];
            v0[0] *= bflo(gw.x); v0[1] *= bfhi(gw.x); v0[2] *= bflo(gw.y); v0[3] *= bfhi(gw.y);
            v1[0] *= bflo(gw.z); v1[1] *= bfhi(gw.z); v1[2] *= bflo(gw.w); v1[3] *= bfhi(gw.w);
            float* t = T + (size_t)row * DM + col;
            *(f32x4*)t = v0; *(f32x4*)(t + 4) = v1;
        }
    }
};
struct EpiGateB {
    static constexpr bool PERM = true, AFTER_DRAIN = false;
    const bf16_t* G; const float* T; bf16_t* MG;
    __device__ __forceinline__ void operator()(const f32x4 (&acc)[2][2][4][2], const Unit& u, int wr, int wc, int fr, int fq) const {
        const int row0 = u.pm * 256 + wr * 64 + fr, c0 = u.pn * 256 + wc * 32 + 8 * fq;
#pragma unroll
        EPI_LOOP {
            const int row = row0 + ai * 128 + m * 16, col = c0 + bj * 128;
            const u32x4 gw = *(const u32x4*)(G + (size_t)row * 2048 + 1024 + col);
            const float* t = T + (size_t)row * DM + col;
            f32x4 v0 = *(const f32x4*)t, v1 = *(const f32x4*)(t + 4);
            const f32x4 a0 = acc[ai][bj][m][0], a1 = acc[ai][bj][m][1];
            v0[0] += a0[0] * bflo(gw.x); v0[1] += a0[1] * bfhi(gw.x); v0[2] += a0[2] * bflo(gw.y); v0[3] += a0[3] * bfhi(gw.y);
            v1[0] += a1[0] * bflo(gw.z); v1[1] += a1[1] * bfhi(gw.z); v1[2] += a1[2] * bflo(gw.w); v1[3] += a1[3] * bfhi(gw.w);
            u32x4 w; w.x = cvt_pk_bf16(v0[0], v0[1]); w.y = cvt_pk_bf16(v0[2], v0[3]); w.z = cvt_pk_bf16(v1[0], v1[1]); w.w = cvt_pk_bf16(v1[2], v1[3]);
            *(u32x4*)(MG + (size_t)row * DM + col) = w;
        }
    }
};
struct EpiF32 {
    static constexpr bool PERM = true, AFTER_DRAIN = false;
    float* T;
    __device__ __forceinline__ void operator()(const f32x4 (&acc)[2][2][4][2], const Unit& u, int wr, int wc, int fr, int fq) const {
        const int row0 = u.pm * 256 + wr * 64 + fr, c0 = u.pn * 256 + wc * 32 + 8 * fq;
#pragma unroll
        EPI_LOOP {
            float* t = T + (size_t)(row0 + ai * 128 + m * 16) * DM + c0 + bj * 128;
            *(f32x4*)t = acc[ai][bj][m][0]; *(f32x4*)(t + 4) = acc[ai][bj][m][1];
        }
    }
};
struct EpiPart {
    static constexpr bool PERM = true, AFTER_DRAIN = false;
    float* TP;
    __device__ __forceinline__ void operator()(const f32x4 (&acc)[2][2][4][2], const Unit& u, int wr, int wc, int fr, int fq) const {
        const int row0 = u.pm * 256 + wr * 64 + fr - MP, c0 = u.pn * 256 + wc * 32 + 8 * fq;
#pragma unroll
        EPI_LOOP {
            float* t = TP + ((size_t)u.ks * MS + row0 + ai * 128 + m * 16) * DM + c0 + bj * 128;
            *(f32x4*)t = acc[ai][bj][m][0]; *(f32x4*)(t + 4) = acc[ai][bj][m][1];
        }
    }
};
struct SplitKOrder {
    int nsplit, ksub, G, c;
    __device__ bool next(int i, Unit& u) const {
        const int L = i * G + c; if (L >= 8 * nsplit) return false;
        const int tile = L & 7; u.pm = 64 + (tile >> 2); u.pn = tile & 3; u.ks = L >> 3; u.ko = u.ks * ksub; return true;
    }
    __device__ __forceinline__ void a_ready(const Unit&) const {}
    __device__ __forceinline__ void done(const Unit&) const {}
};
struct EpiUp {
    static constexpr bool PERM = true, AFTER_DRAIN = false;
    bf16_t* U;
    __device__ __forceinline__ void operator()(const f32x4 (&acc)[2][2][4][2], const Unit& u, int wr, int wc, int fr, int fq) const {
        const int row0 = u.pm * 256 + wr * 64 + fr, c0 = u.pn * 256 + wc * 32 + 8 * fq;
#pragma unroll
        EPI_LOOP {
            const int row = row0 + ai * 128 + m * 16, col = c0 + bj * 128;
            f32x4 v0 = acc[ai][bj][m][0], v1 = acc[ai][bj][m][1];
#pragma unroll
            for (int e = 0; e < 4; ++e) { const float a = fmaxf(v0[e], 0.f), b = fmaxf(v1[e], 0.f); v0[e] = a * a; v1[e] = b * b; }
            u32x4 w; w.x = cvt_pk_bf16(v0[0], v0[1]); w.y = cvt_pk_bf16(v0[2], v0[3]); w.z = cvt_pk_bf16(v1[0], v1[1]); w.w = cvt_pk_bf16(v1[2], v1[3]);
            *(u32x4*)(U + (size_t)row * FF + col) = w;
        }
    }
};

__device__ __forceinline__ void p0_transpose_item(const float* W, int K, int N, bf16_t* WT, LAS float* scr, int item, int lane) {
    const int nblk = N / 32, kb = item / nblk, nb = item % nblk, k0 = 64 * kb, n0 = 32 * nb;
#pragma unroll 8
    for (int i = 0; i < 32; ++i) { const int kk = 2 * i + (lane >> 5); scr[kk * 33 + (lane & 31)] = W[(size_t)(k0 + kk) * N + n0 + (lane & 31)]; }
    asm volatile("s_waitcnt lgkmcnt(0)" ::: "memory");
    const int c = lane & 7;
#pragma unroll
    for (int j = 0; j < 4; ++j) { const int n = (lane >> 3) + 8 * j; const LAS float* s = scr + (8 * c) * 33 + n;
        u32x4 o; o.x = pk2(s[0 * 33], s[1 * 33]); o.y = pk2(s[2 * 33], s[3 * 33]); o.z = pk2(s[4 * 33], s[5 * 33]); o.w = pk2(s[6 * 33], s[7 * 33]);
        *(u32x4*)(WT + (size_t)(n0 + n) * K + k0 + 8 * c) = o; }
    asm volatile("s_waitcnt lgkmcnt(0)" ::: "memory");
}

struct KArgs { const float* in[20]; float* out; unsigned char* ws; };

__device__ __forceinline__ const float* xrow_ptr(const KArgs& a, int row) { return row < MP ? a.in[0] + (size_t)row * DM : a.in[1] + (size_t)(row - MP) * DM; }

__device__ __forceinline__ void p0_prologue(const KArgs& a, LAS unsigned char* lds, int wave, int lane, int gw, int NGW) {
    unsigned char* ws = a.ws;
    LAS float* scr = (LAS float*)(lds + wave * 16384);
    constexpr int I0 = (1024 / 64) * (NIN / 32), I1 = (256 / 64) * (1024 / 32), I2 = (512 / 64) * (1024 / 32), I3 = (1024 / 64) * (1024 / 32), I4 = (1024 / 64) * (FF / 32), I5 = (FF / 64) * (1024 / 32);
    constexpr int NIT = I0 + I1 + I2 + I3 + I4 + I5;
    for (int it = gw; it < NIT; it += NGW) {
        int r = it;
        if (r < I0) { p0_transpose_item(a.in[6], 1024, NIN, (bf16_t*)(ws + WS_WIN), scr, r, lane); continue; } r -= I0;
        if (r < I1) { p0_transpose_item(a.in[12], 256, 1024, (bf16_t*)(ws + WS_WAO), scr, r, lane); continue; } r -= I1;
        if (r < I2) { p0_transpose_item(a.in[13], 512, 1024, (bf16_t*)(ws + WS_WBO), scr, r, lane); continue; } r -= I2;
        if (r < I3) { p0_transpose_item(a.in[14], 1024, 1024, (bf16_t*)(ws + WS_WOUT), scr, r, lane); continue; } r -= I3;
        if (r < I4) { p0_transpose_item(a.in[17], 1024, FF, (bf16_t*)(ws + WS_WUP), scr, r, lane); continue; } r -= I4;
        p0_transpose_item(a.in[18], FF, 1024, (bf16_t*)(ws + WS_WDN), scr, r, lane);
    }
    const float* gain = a.in[5];
    bf16_t* XN = (bf16_t*)(ws + WS_XN);
    for (int row = gw; row < MT; row += NGW) {
        const f32x4* xr = (const f32x4*)xrow_ptr(a, row) + lane;
        f32x4 v[4]; float s = 0.f;
#pragma unroll
        for (int j = 0; j < 4; ++j) { v[j] = xr[64 * j]; s += (v[j][0] * v[j][0] + v[j][1] * v[j][1]) + (v[j][2] * v[j][2] + v[j][3] * v[j][3]); }
        const float r = rsqrtf(wave_sum(s) * (1.f / DM) + EPS);
        u32x2* o = (u32x2*)(XN + (size_t)row * DM) + lane;
#pragma unroll
        for (int j = 0; j < 4; ++j) { const f32x4 g = ((const f32x4*)gain)[lane + 64 * j]; u32x2 w; w.x = pk2(v[j][0] * r * g[0], v[j][1] * r * g[1]); w.y = pk2(v[j][2] * r * g[2], v[j][3] * r * g[3]); o[64 * j] = w; }
    }
}

constexpr int OST_ROW = 136;
__device__ __forceinline__ void attn_prompt_unit(int u, const bf16_t* QKV, const bf16_t* VT, bf16_t* OA, LAS unsigned char* lds, int wave, int lane) {
    const int b = u >> 5, blk = (u >> 2) & 7, h = u & 3, s0 = blk * 256;
    const int q = lane & 15, c = lane >> 4;
    LAS float* lse_s = (LAS float*)(lds + 3 * 256 * OST_ROW);
    for (int jj = 0; jj < 6; ++jj) {
        const int g = jj >> 1, sub = 2 * wave + (jj & 1), sh = 2 * g, L = 2048 >> sh;
        int r, m0;
        if (g == 0) { r = 0; m0 = s0 + 16 * sub; } else if (g == 1) { r = sub >> 2; m0 = (s0 >> 2) + 16 * (sub & 3); } else { r = sub; m0 = s0 >> 4; }
        const int ktmin = 9 - (m0 >> 4);
        const bf16_t* qrow = QKV + (size_t)(b * 2048 + ((m0 + q) << sh) + r) * NQKV + g * 256 + h * 64 + 8 * c;
        const bf16x8 qf0 = *(const bf16x8*)qrow, qf1 = *(const bf16x8*)(qrow + 32);
        f32x4 st[9];
#pragma unroll
        for (int kt = 1; kt <= 9; ++kt) {
            f32x4 sa = {-1e30f, -1e30f, -1e30f, -1e30f};
            if (kt >= ktmin) {
                const int mk = m0 - 144 + 16 * kt + q;
                const bf16_t* krow = QKV + (size_t)(b * 2048 + (mk << sh) + r) * NQKV + 768 + g * 256 + h * 64 + 8 * c;
                const bf16x8 k0 = *(const bf16x8*)krow, k1 = *(const bf16x8*)(krow + 32);
                f32x4 z = {0.f, 0.f, 0.f, 0.f};
                z = mfma16(k0, qf0, z); z = mfma16(k1, qf1, z);
                if (kt == 1) {
#pragma unroll
                    for (int i = 0; i < 4; ++i) if (4 * c + i < q) z[i] = -1e30f;
                }
                if (kt == 9) {
#pragma unroll
                    for (int i = 0; i < 4; ++i) if (4 * c + i > q) z[i] = -1e30f;
                }
                sa = z;
            }
            st[kt - 1] = sa;
        }
        float mx = -1e30f;
#pragma unroll
        for (int t = 0; t < 9; ++t) mx = fmaxf(mx, fmaxf(fmaxf(st[t][0], st[t][1]), fmaxf(st[t][2], st[t][3])));
        mx = fmaxf(mx, __shfl_xor(mx, 16)); mx = fmaxf(mx, __shfl_xor(mx, 32));
        float ls = 0.f;
#pragma unroll
        for (int t = 0; t < 9; ++t)
#pragma unroll
            for (int i = 0; i < 4; ++i) { const float p = exp2f((st[t][i] - mx) * (SCALE * LOG2E)); st[t][i] = p; ls += p; }
        ls += __shfl_xor(ls, 16); ls += __shfl_xor(ls, 32);
        bf16x8 pf[5];
#pragma unroll
        for (int kb = 0; kb < 5; ++kb) {
            u32x4 w;
            if (kb == 0) { w.x = 0u; w.y = 0u; } else { w.x = cvt_pk_bf16(st[2 * kb - 1][0], st[2 * kb - 1][1]); w.y = cvt_pk_bf16(st[2 * kb - 1][2], st[2 * kb - 1][3]); }
            w.z = cvt_pk_bf16(st[2 * kb][0], st[2 * kb][1]); w.w = cvt_pk_bf16(st[2 * kb][2], st[2 * kb][3]);
            pf[kb] = __builtin_bit_cast(bf16x8, w);
        }
        f32x4 oacc[4];
#pragma unroll
        for (int dt = 0; dt < 4; ++dt) {
            f32x4 o = {0.f, 0.f, 0.f, 0.f};
            const bf16_t* vrow = VT + (size_t)(((b * 3 + g) * 4 + h) * 64 + 16 * dt + q) * 2048 + r * L + 4 * c;
#pragma unroll
            for (int kb = 0; kb < 5; ++kb) {
                if (2 * kb + 1 >= ktmin) {
                    const int mA = m0 - 144 + 32 * kb;
                    u32x2 lo = {0u, 0u}, hi;
                    if (kb > 0 && 2 * kb >= ktmin) lo = *(const u32x2*)(vrow + mA);
                    hi = *(const u32x2*)(vrow + mA + 16);
                    u32x4 w; w.x = lo.x; w.y = lo.y; w.z = hi.x; w.w = hi.y;
                    o = mfma16(__builtin_bit_cast(bf16x8, w), pf[kb], o);
                }
            }
            oacc[dt] = o;
        }
        const float inv = 1.f / ls;
        const int tok = ((m0 + q) << sh) + r - s0;
        LAS unsigned char* orow = lds + (g * 256 + tok) * OST_ROW + 8 * c;
#pragma unroll
        for (int dt = 0; dt < 4; ++dt) {
            u32x2 w; w.x = cvt_pk_bf16(oacc[dt][0] * inv, oacc[dt][1] * inv); w.y = cvt_pk_bf16(oacc[dt][2] * inv, oacc[dt][3] * inv);
            *(LAS u32x2*)(orow + 32 * dt) = w;
        }
        if (c == 0) lse_s[g * 256 + tok] = mx * SCALE + __logf(ls);
    }
    __syncthreads();
    {
        const int tid = wave * 64 + lane, tok = tid >> 1, half = tid & 1;
        const float l0 = lse_s[tok], l1 = lse_s[256 + tok], l2 = lse_s[512 + tok];
        const float mm = fmaxf(l0, fmaxf(l1, l2));
        float e0 = __expf(l0 - mm), e1 = __expf(l1 - mm), e2 = __expf(l2 - mm);
        const float inv = 1.f / (e0 + e1 + e2); e0 *= inv; e1 *= inv; e2 *= inv;
        bf16_t* dst = OA + (size_t)(b * 2048 + s0 + tok) * 256 + h * 64 + half * 32;
#pragma unroll
        for (int ch = 0; ch < 4; ++ch) {
            float o[8];
#pragma unroll
            for (int k2 = 0; k2 < 2; ++k2) {
                const int off = tok * OST_ROW + half * 64 + ch * 16 + k2 * 8;
                const u32x2 a0 = *(const LAS u32x2*)(lds + off), a1 = *(const LAS u32x2*)(lds + 256 * OST_ROW + off), a2 = *(const LAS u32x2*)(lds + 512 * OST_ROW + off);
                o[4 * k2 + 0] = e0 * bflo(a0.x) + e1 * bflo(a1.x) + e2 * bflo(a2.x); o[4 * k2 + 1] = e0 * bfhi(a0.x) + e1 * bfhi(a1.x) + e2 * bfhi(a2.x);
                o[4 * k2 + 2] = e0 * bflo(a0.y) + e1 * bflo(a1.y) + e2 * bflo(a2.y); o[4 * k2 + 3] = e0 * bfhi(a0.y) + e1 * bfhi(a1.y) + e2 * bfhi(a2.y);
            }
            u32x4 w; w.x = cvt_pk_bf16(o[0], o[1]); w.y = cvt_pk_bf16(o[2], o[3]); w.z = cvt_pk_bf16(o[4], o[5]); w.w = cvt_pk_bf16(o[6], o[7]);
            *(u32x4*)(dst + 8 * ch) = w;
        }
    }
    __syncthreads();
}

constexpr int ZT_ROW = 272;
__device__ __forceinline__ void sgate_prompt_unit(int u, const bf16_t* Z, const float* lng, const float* lnb, const float* Wsp, const float* bsp, bf16_t* OB, LAS unsigned char* lds, int wave, int lane) {
    const int chunk = u >> 2, gg = u & 3;
    for (int i = 0; i < 16; ++i) {
        const int tok = wave * 16 + i; const size_t row = (size_t)chunk * 128 + tok;
        const u32x4 raw = *(const u32x4*)(Z + row * 1024 + 512 + 8 * lane);
        float x[8] = {bflo(raw.x), bfhi(raw.x), bflo(raw.y), bfhi(raw.y), bflo(raw.z), bfhi(raw.z), bflo(raw.w), bfhi(raw.w)};
        float s = 0.f;
#pragma unroll
        for (int e = 0; e < 8; ++e) s += x[e];
        const float mean = wave_sum(s) * (1.f / 512.f); float s2 = 0.f;
#pragma unroll
        for (int e = 0; e < 8; ++e) { x[e] -= mean; s2 += x[e] * x[e]; }
        const float rstd = rsqrtf(wave_sum(s2) * (1.f / 512.f) + EPS);
        if ((lane >> 4) == gg) {
            const int fl = 8 * (lane & 15);
#pragma unroll
            for (int e = 0; e < 8; ++e) { const float zn = x[e] * rstd * lng[8 * lane + e] + lnb[8 * lane + e]; *(LAS bf16_t*)(lds + (fl + e) * ZT_ROW + tok * 2) = (bf16_t)f2bf(zn); }
        }
    }
    __syncthreads();
    const int q = lane & 15, c = lane >> 4, t = wave * 16 + q;
    f32x4 acc[8];
#pragma unroll
    for (int kt = 0; kt < 8; ++kt) acc[kt] = (f32x4){0.f, 0.f, 0.f, 0.f};
    const int nks = (wave >> 1) + 1;
    for (int ks = 0; ks < nks; ++ks) {
        const float* wp = Wsp + ((size_t)gg * 128 + t) * 128 + 32 * ks + 8 * c;
        f32x4 w0 = *(const f32x4*)wp, w1 = *(const f32x4*)(wp + 4);
        const int sb = 32 * ks + 8 * c;
#pragma unroll
        for (int e = 0; e < 4; ++e) { if (sb + e > t) w0[e] = 0.f; if (sb + 4 + e > t) w1[e] = 0.f; }
        u32x4 aw; aw.x = cvt_pk_bf16(w0[0], w0[1]); aw.y = cvt_pk_bf16(w0[2], w0[3]); aw.z = cvt_pk_bf16(w1[0], w1[1]); aw.w = cvt_pk_bf16(w1[2], w1[3]);
        const bf16x8 af = __builtin_bit_cast(bf16x8, aw);
#pragma unroll
        for (int kt = 0; kt < 8; ++kt) {
            const bf16x8 bfr = *(const LAS bf16x8*)(lds + (16 * kt + q) * ZT_ROW + sb * 2);
            acc[kt] = mfma16(af, bfr, acc[kt]);
        }
    }
#pragma unroll
    for (int i = 0; i < 4; ++i) {
        const int tt = wave * 16 + 4 * c + i; const size_t row = (size_t)chunk * 128 + tt; const float bb = bsp[gg * 128 + tt];
#pragma unroll
        for (int kt = 0; kt < 8; ++kt) {
            const int col = gg * 128 + 16 * kt + q;
            const float z1 = bf2f(Z[row * 1024 + col]);
            OB[row * 512 + col] = (bf16_t)f2bf(z1 * (acc[kt][i] + bb));
        }
    }
    __syncthreads();
}

__device__ __forceinline__ void attn_sample_item(int it, const KArgs& a, const bf16_t* QKV, bf16_t* OA, LAS unsigned char* lds, int wave, int lane) {
    const int db = it >> 2, t = it & 3;
    LAS float* pm = (LAS float*)lds;
    LAS float* pl = pm + 32;
    LAS float* pacc = pm + 64;
    if (wave < 6) {
        const int g = wave % 3, half = wave / 3, sh = 2 * g, wb = 128 << sh;
        const float* cache = (g == 0 ? a.in[2] : (g == 1 ? a.in[3] : a.in[4])) + (size_t)db * wb * 512;
        const int hh = lane >> 4, dd = 4 * (lane & 15);
        const size_t rowq = (size_t)(MP + db * 4 + t) * NQKV;
        const u32x2 qw = *(const u32x2*)(QKV + rowq + g * 256 + hh * 64 + dd);
        const float q0 = bflo(qw.x), q1 = bfhi(qw.x), q2 = bflo(qw.y), q3 = bfhi(qw.y);
        float m = -1e30f, l = 0.f, a0 = 0.f, a1 = 0.f, a2 = 0.f, a3 = 0.f;
        const int jn = t >> sh;
        int jlo = jn + 1, jhi = 65;
        if (half == 0) {
            for (int j = 0; j <= jn; ++j) {
                const size_t rk = (size_t)(MP + db * 4 + t - (j << sh)) * NQKV + g * 256 + hh * 64 + dd;
                const u32x2 kw = *(const u32x2*)(QKV + rk + 768), vw = *(const u32x2*)(QKV + rk + 1536);
                float d = q0 * bflo(kw.x) + q1 * bfhi(kw.x) + q2 * bflo(kw.y) + q3 * bfhi(kw.y);
                d += __shfl_xor(d, 1); d += __shfl_xor(d, 2); d += __shfl_xor(d, 4); d += __shfl_xor(d, 8);
                const float sc = d * SCALE, mn = fmaxf(m, sc), cr = __expf(m - mn), p = __expf(sc - mn);
                l = l * cr + p; a0 = a0 * cr + p * bflo(vw.x); a1 = a1 * cr + p * bfhi(vw.x); a2 = a2 * cr + p * bflo(vw.y); a3 = a3 * cr + p * bfhi(vw.y); m = mn;
            }
        } else { jlo = 65; jhi = 129; }
        for (int j0 = jlo; j0 < jhi; j0 += 8) {
            f32x4 kk[8], vv[8];
#pragma unroll
            for (int e = 0; e < 8; ++e) {
                const int j = min(j0 + e, jhi - 1);
                const float* p = cache + (size_t)(wb + t - (j << sh)) * 512 + hh * 64 + dd;
                kk[e] = *(const f32x4*)p; vv[e] = *(const f32x4*)(p + 256);
            }
#pragma unroll
            for (int e = 0; e < 8; ++e) {
                float d = q0 * kk[e][0] + q1 * kk[e][1] + q2 * kk[e][2] + q3 * kk[e][3];
                d += __shfl_xor(d, 1); d += __shfl_xor(d, 2); d += __shfl_xor(d, 4); d += __shfl_xor(d, 8);
                const float sc = (j0 + e < jhi) ? d * SCALE : -1e30f;
                const float mn = fmaxf(m, sc), cr = __expf(m - mn), p = __expf(sc - mn);
                l = l * cr + p; a0 = a0 * cr + p * vv[e][0]; a1 = a1 * cr + p * vv[e][1]; a2 = a2 * cr + p * vv[e][2]; a3 = a3 * cr + p * vv[e][3]; m = mn;
            }
        }
        if ((lane & 15) == 0) { pm[wave * 4 + hh] = m; pl[wave * 4 + hh] = l; }
        *(LAS f32x4*)(pacc + wave * 256 + hh * 64 + dd) = (f32x4){a0, a1, a2, a3};
    }
    __syncthreads();
    {
        const int tid = wave * 64 + lane;
        if (tid < 256) {
            const int hh = tid >> 6;
            float mm = -1e30f;
#pragma unroll
            for (int w = 0; w < 6; ++w) mm = fmaxf(mm, pm[w * 4 + hh]);
            float ll = 0.f, o = 0.f;
#pragma unroll
            for (int w = 0; w < 6; ++w) { const float e = __expf(pm[w * 4 + hh] - mm); ll += pl[w * 4 + hh] * e; o += pacc[w * 256 + tid] * e; }
            OA[(size_t)(MP + db * 4 + t) * 256 + tid] = (bf16_t)f2bf(o / ll);
        }
    }
    __syncthreads();
}

__device__ __forceinline__ void sgate_sample_item(int db, const KArgs& a, const bf16_t* Z, bf16_t* OB, int lane) {
    const float* lng = a.in[8]; const float* lnb = a.in[9]; const float* Wsp = a.in[10]; const float* bsp = a.in[11];
    float zn[4][8];
    const int gg = lane >> 4;
#pragma unroll
    for (int t = 0; t < 4; ++t) {
        const size_t row = (size_t)MP + db * 4 + t;
        const u32x4 raw = *(const u32x4*)(Z + row * 1024 + 512 + 8 * lane);
        float x[8] = {bflo(raw.x), bfhi(raw.x), bflo(raw.y), bfhi(raw.y), bflo(raw.z), bfhi(raw.z), bflo(raw.w), bfhi(raw.w)};
        float s = 0.f;
#pragma unroll
        for (int e = 0; e < 8; ++e) s += x[e];
        const float mean = wave_sum(s) * (1.f / 512.f); float s2 = 0.f;
#pragma unroll
        for (int e = 0; e < 8; ++e) { x[e] -= mean; s2 += x[e] * x[e]; }
        const float rstd = rsqrtf(wave_sum(s2) * (1.f / 512.f) + EPS);
#pragma unroll
        for (int e = 0; e < 8; ++e) zn[t][e] = x[e] * rstd * lng[8 * lane + e] + lnb[8 * lane + e];
        float* so = a.out + O_SG + (size_t)(db * 4 + t) * 512 + 8 * lane;
        *(f32x4*)so = (f32x4){zn[t][0], zn[t][1], zn[t][2], zn[t][3]}; *(f32x4*)(so + 4) = (f32x4){zn[t][4], zn[t][5], zn[t][6], zn[t][7]};
    }
#pragma unroll
    for (int t = 0; t < 4; ++t) {
        const size_t row = (size_t)MP + db * 4 + t;
        const float bb = bsp[gg * 128 + t];
        float mix[8];
#pragma unroll
        for (int e = 0; e < 8; ++e) mix[e] = bb;
#pragma unroll
        for (int s = 0; s <= t; ++s) { const float w = Wsp[((size_t)gg * 128 + t) * 128 + s];
#pragma unroll
            for (int e = 0; e < 8; ++e) mix[e] += w * zn[s][e]; }
        const u32x4 zw = *(const u32x4*)(Z + row * 1024 + 8 * lane);
        u32x4 w; w.x = cvt_pk_bf16(bflo(zw.x) * mix[0], bfhi(zw.x) * mix[1]); w.y = cvt_pk_bf16(bflo(zw.y) * mix[2], bfhi(zw.y) * mix[3]);
        w.z = cvt_pk_bf16(bflo(zw.z) * mix[4], bfhi(zw.z) * mix[5]); w.w = cvt_pk_bf16(bflo(zw.w) * mix[6], bfhi(zw.w) * mix[7]);
        *(u32x4*)(OB + row * 512 + 8 * lane) = w;
    }
}

#define XB_TMO      128
#define XB_XCNT(j)  (256  + 64 * (j))
#define XB_XSUB(j)  (1280 + 64 * (j))
#define XB_XGEN(j)  (2304 + 64 * (j))
#define XB_TOP      3328
#define XB_TOPGEN   3392
#define XCD_BAR_WORDS 3456
#define XB_SPIN_CAP (1u << 18)

__device__ __forceinline__ unsigned xb_ld(unsigned* p)              { return __hip_atomic_load(p, __ATOMIC_RELAXED, __HIP_MEMORY_SCOPE_AGENT); }
__device__ __forceinline__ unsigned xb_add(unsigned* p, unsigned v) { return __hip_atomic_fetch_add(p, v, __ATOMIC_RELAXED, __HIP_MEMORY_SCOPE_AGENT); }
__device__ __forceinline__ unsigned xb_xcc_id() { return (unsigned)__builtin_amdgcn_s_getreg((3 << 11) | 20) & 0xFu; }
#define XB_SPIN(cond, bar) do { unsigned _sp = 0; while (cond) { __builtin_amdgcn_s_sleep(1); \
    if ((++_sp & 255u) == 0u) { if (xb_ld(&(bar)[XB_TMO])) break; if (_sp > XB_SPIN_CAP) { atomicAdd(&(bar)[XB_TMO], 1u); break; } } } } while (0)

struct XcdBarrier {
    unsigned* bar; unsigned x;
    volatile LAS unsigned* st;
};

__device__ __forceinline__ XcdBarrier xcd_barrier_post(unsigned* bar, volatile LAS unsigned* st) {
    XcdBarrier b; b.bar = bar; b.x = xb_xcc_id(); b.st = st;
    if (threadIdx.x == 0) (void)xb_add(&bar[XB_XCNT(b.x)], 1u);
    return b;
}
__device__ __forceinline__ void xcd_barrier_complete(unsigned* bar, unsigned x, unsigned& nloc, unsigned& nx) {
    const unsigned G = gridDim.x * gridDim.y * gridDim.z;
    unsigned sum, cnt, mine, sp = 0u;
    for (;;) {
        sum = 0u; cnt = 0u; mine = 0u;
#pragma unroll
        for (unsigned j = 0; j < 16; ++j) { const unsigned c = xb_ld(&bar[XB_XCNT(j)]); sum += c; cnt += (c > 0u) ? 1u : 0u; mine = (j == x) ? c : mine; }
        if (sum == G) break;
        __builtin_amdgcn_s_sleep(1);
        if ((++sp & 255u) == 0u) { if (xb_ld(&bar[XB_TMO])) break; if (sp > XB_SPIN_CAP) { atomicAdd(&bar[XB_TMO], 1u); break; } }
    }
    nloc = mine > 0u ? mine : 1u; nx = cnt > 0u ? cnt : 1u;
}

__device__ __forceinline__ void xcd_barrier(const XcdBarrier& b) {
    asm volatile("s_waitcnt vmcnt(0)" ::: "memory");
    __syncthreads();
    if (threadIdx.x == 0) {
        unsigned* bar = b.bar;
        __builtin_amdgcn_s_waitcnt(0);
        unsigned nloc = b.st[0], nx = b.st[1];
        if (nloc == 0u) { xcd_barrier_complete(bar, b.x, nloc, nx); b.st[0] = nloc; b.st[1] = nx; }
        const unsigned old = xb_add(&bar[XB_XSUB(b.x)], 1u);
        const unsigned gen = old / nloc;
        if (old + 1u == (gen + 1u) * nloc) {
            __builtin_amdgcn_fence(__ATOMIC_RELEASE, "agent");
            asm volatile("s_waitcnt vmcnt(0)" ::: "memory");
            const unsigned og = xb_add(&bar[XB_TOP], 1u);
            const unsigned tg = og / nx;
            if (og + 1u == (tg + 1u) * nx) xb_add(&bar[XB_TOPGEN], 1u);
            else XB_SPIN(xb_ld(&bar[XB_TOPGEN]) == tg, bar);
            __builtin_amdgcn_fence(__ATOMIC_ACQUIRE, "agent");
            xb_add(&bar[XB_XGEN(b.x)], 1u);
            asm volatile("s_waitcnt vmcnt(0)" ::: "memory");
        } else {
            XB_SPIN(xb_ld(&bar[XB_XGEN(b.x)]) == gen, bar);
            __builtin_amdgcn_fence(__ATOMIC_ACQUIRE, "agent");
            asm volatile("s_waitcnt vmcnt(0)" ::: "memory");
        }
    }
    __syncthreads();
}

#ifndef REP_A
#define REP_A 1
#define REP_B 1
#define REP_C 1
#define REP_P1 1
#define REP_P5 1
#define REP_SYNC 0
#endif
#ifndef PHM
#define PHM 0x1fff
#endif
__global__ void __launch_bounds__(512, 2) fwd_megakernel(KArgs a) {
    extern __shared__ __attribute__((aligned(16))) unsigned char lds_raw[];
    cg::grid_group grid = cg::this_grid();
    LAS unsigned char* lds = (LAS unsigned char*)lds_raw;
    const int G = gridDim.x, bid = blockIdx.x, NGW = G * 8;
#define FRESH_IDS int tid_ = threadIdx.x; asm volatile("" : "+v"(tid_)); const int lane = tid_ & 63, wave = __builtin_amdgcn_readfirstlane(tid_ >> 6), gw = bid * 8 + wave; (void)gw; (void)lane;
    unsigned char* ws = a.ws;
    volatile LAS unsigned* bst = (volatile LAS unsigned*)(lds + 131072 + 64);
    if (threadIdx.x < 2) bst[threadIdx.x] = 0u;
    __syncthreads();
    const XcdBarrier xbar = xcd_barrier_post((unsigned*)(ws + WS_BAR), bst);
#define SEAM() xcd_barrier(xbar)
    bf16_t* XN = (bf16_t*)(ws + WS_XN); bf16_t* QKV = (bf16_t*)(ws + WS_QKV); bf16_t* VT = (bf16_t*)(ws + WS_VT); bf16_t* Zb = (bf16_t*)(ws + WS_Z);
    bf16_t* Gb = (bf16_t*)(ws + WS_G); bf16_t* OA = (bf16_t*)(ws + WS_OA); bf16_t* OB = (bf16_t*)(ws + WS_OB); float* T = (float*)(ws + WS_T);
    bf16_t* MG = (bf16_t*)(ws + WS_MG); bf16_t* U = (bf16_t*)(ws + WS_U); float* TP = (float*)(ws + WS_TP);

    if (PHM & 1) { FRESH_IDS p0_prologue(a, lds, wave, lane, gw, NGW); }
    grid.sync();
    if (PHM & 2) {
        pg8::Gemm g{XN, (const bf16_t*)(ws + WS_WIN), MT, NIN, DM, DM, DM}; pg8::StaticOrder S; S.init(MT, NIN, G, bid);
        EpiIn E{QKV, VT, Zb, Gb, a.out, a.in[7]};
        pg8::gemm_phase<EpiIn, pg8::StaticOrder, true, true>(lds, g, S, E);
#if REP_P1 > 1
        pg8::gemm_phase<EpiIn, pg8::StaticOrder, true, true>(lds, g, S, E);
#endif
    }
    SEAM();
    if (PHM & 4) { FRESH_IDS for (int u = bid; u < 256; u += G) attn_prompt_unit(u, QKV, VT, OA, lds, wave, lane); }
#if REP_A > 1
    if (PHM & 4) { FRESH_IDS for (int u = bid; u < 256; u += G) attn_prompt_unit(u, QKV, VT, OA, lds, wave, lane); }
#endif
    if (PHM & 8) { FRESH_IDS for (int u = bid; u < 512; u += G) sgate_prompt_unit(u, Zb, a.in[8], a.in[9], a.in[10], a.in[11], OB, lds, wave, lane); }
#if REP_B > 1
    if (PHM & 8) { FRESH_IDS for (int u = bid; u < 512; u += G) sgate_prompt_unit(u, Zb, a.in[8], a.in[9], a.in[10], a.in[11], OB, lds, wave, lane); }
#endif
    if (PHM & 16) { FRESH_IDS for (int it = bid; it < MS; it += G) attn_sample_item(it, a, QKV, OA, lds, wave, lane); }
#if REP_C > 1
    if (PHM & 16) { FRESH_IDS for (int it = bid; it < MS; it += G) attn_sample_item(it, a, QKV, OA, lds, wave, lane); }
#endif
    if (PHM & 32) { FRESH_IDS for (int db = gw; db < 128; db += NGW) sgate_sample_item(db, a, Zb, OB, lane); }
    SEAM();
    if (PHM & 64) {
        pg8::Gemm g{OA, (const bf16_t*)(ws + WS_WAO), MT, DM, 256, 256, 256}; pg8::StaticOrder S; S.init(MT, DM, G, bid);
        EpiGateA E{Gb, T};
        pg8::gemm_phase<EpiGateA, pg8::StaticOrder, true, true>(lds, g, S, E);
    }
    if (PHM & 128) {
        pg8::Gemm g{OB, (const bf16_t*)(ws + WS_WBO), MT, DM, 512, 512, 512}; pg8::StaticOrder S; S.init(MT, DM, G, bid);
        EpiGateB E{Gb, T, MG};
        pg8::gemm_phase<EpiGateB, pg8::StaticOrder, true, true>(lds, g, S, E);
    }
    SEAM();
    if (PHM & 256) {
        pg8::Gemm g{MG, (const bf16_t*)(ws + WS_WOUT), MP, DM, DM, DM, DM}; pg8::StaticOrder S; S.init(MP, DM, G, bid);
        EpiF32 E{T};
        pg8::gemm_phase<EpiF32, pg8::StaticOrder, true, true>(lds, g, S, E);
        pg8::Gemm g2{MG, (const bf16_t*)(ws + WS_WOUT), MT, DM, 256, DM, DM}; SplitKOrder S2{4, 256, G, bid};
        EpiPart E2{TP};
        pg8::gemm_phase<EpiPart, SplitKOrder, true, true>(lds, g2, S2, E2);
    }
    SEAM();
    if (PHM & 512) {
        FRESH_IDS
        const float* g1 = a.in[15]; const float* g2 = a.in[16];
        for (int row = gw; row < MT; row += NGW) {
            const f32x4* xr = (const f32x4*)xrow_ptr(a, row) + lane;
            f32x4 t[4]; float s1 = 0.f;
            if (row < MP) {
                const f32x4* tr = (const f32x4*)(T + (size_t)row * DM) + lane;
#pragma unroll
                for (int j = 0; j < 4; ++j) t[j] = tr[64 * j];
            } else {
#pragma unroll
                for (int j = 0; j < 4; ++j) t[j] = (f32x4){0.f, 0.f, 0.f, 0.f};
                for (int ks = 0; ks < 4; ++ks) { const f32x4* tr = (const f32x4*)(TP + ((size_t)ks * MS + row - MP) * DM) + lane;
#pragma unroll
                    for (int j = 0; j < 4; ++j) t[j] += tr[64 * j]; }
            }
#pragma unroll
            for (int j = 0; j < 4; ++j) s1 += (t[j][0] * t[j][0] + t[j][1] * t[j][1]) + (t[j][2] * t[j][2] + t[j][3] * t[j][3]);
            const float r1 = rsqrtf(wave_sum(s1) * (1.f / DM) + EPS);
            f32x4 v[4]; float s = 0.f;
#pragma unroll
            for (int j = 0; j < 4; ++j) { const f32x4 x = xr[64 * j], g = ((const f32x4*)g1)[lane + 64 * j];
                v[j] = x + t[j] * r1 * g; s += (v[j][0] * v[j][0] + v[j][1] * v[j][1]) + (v[j][2] * v[j][2] + v[j][3] * v[j][3]); }
            const float r2 = rsqrtf(wave_sum(s) * (1.f / DM) + EPS);
            f32x4* yo = (f32x4*)(a.out + O_Y + (size_t)row * DM) + lane; u32x2* ho = (u32x2*)(XN + (size_t)row * DM) + lane;
#pragma unroll
            for (int j = 0; j < 4; ++j) { const f32x4 g = ((const f32x4*)g2)[lane + 64 * j]; yo[64 * j] = v[j];
                u32x2 w; w.x = pk2(v[j][0] * r2 * g[0], v[j][1] * r2 * g[1]); w.y = pk2(v[j][2] * r2 * g[2], v[j][3] * r2 * g[3]); ho[64 * j] = w; }
        }
    }
    SEAM();
    if (PHM & 1024) {
        pg8::Gemm g{XN, (const bf16_t*)(ws + WS_WUP), MT, FF, DM, DM, DM}; pg8::StaticOrder S; S.init(MT, FF, G, bid);
        EpiUp E{U};
        pg8::gemm_phase<EpiUp, pg8::StaticOrder, true, true>(lds, g, S, E);
#if REP_P5 > 1
        pg8::gemm_phase<EpiUp, pg8::StaticOrder, true, true>(lds, g, S, E);
#endif
    }
    SEAM();
    if (PHM & 2048) {
        pg8::Gemm g{U, (const bf16_t*)(ws + WS_WDN), MP, DM, FF, FF, FF}; pg8::StaticOrder S; S.init(MP, DM, G, bid);
        EpiF32 E{T};
        pg8::gemm_phase<EpiF32, pg8::StaticOrder, true, true>(lds, g, S, E);
        pg8::Gemm g2{U, (const bf16_t*)(ws + WS_WDN), MT, DM, 256, FF, FF}; SplitKOrder S2{16, 256, G, bid};
        EpiPart E2{TP};
        pg8::gemm_phase<EpiPart, SplitKOrder, true, true>(lds, g2, S2, E2);
    }
    SEAM();
#if REP_SYNC > 0
    for (int i = 0; i < REP_SYNC; ++i) grid.sync();
#endif
    if (PHM & 4096) {
        FRESH_IDS
        const float* g3 = a.in[19];
        for (int row = gw; row < MT; row += NGW) {
            f32x4* yo = (f32x4*)(a.out + O_Y + (size_t)row * DM) + lane;
            f32x4 t[4]; float s1 = 0.f;
            if (row < MP) {
                const f32x4* tr = (const f32x4*)(T + (size_t)row * DM) + lane;
#pragma unroll
                for (int j = 0; j < 4; ++j) t[j] = tr[64 * j];
            } else {
#pragma unroll
                for (int j = 0; j < 4; ++j) t[j] = (f32x4){0.f, 0.f, 0.f, 0.f};
                for (int ks = 0; ks < 16; ++ks) { const f32x4* tr = (const f32x4*)(TP + ((size_t)ks * MS + row - MP) * DM) + lane;
#pragma unroll
                    for (int j = 0; j < 4; ++j) t[j] += tr[64 * j]; }
            }
#pragma unroll
            for (int j = 0; j < 4; ++j) s1 += (t[j][0] * t[j][0] + t[j][1] * t[j][1]) + (t[j][2] * t[j][2] + t[j][3] * t[j][3]);
            const float r3 = rsqrtf(wave_sum(s1) * (1.f / DM) + EPS);
#pragma unroll
            for (int j = 0; j < 4; ++j) { const f32x4 g = ((const f32x4*)g3)[lane + 64 * j]; yo[64 * j] = yo[64 * j] + t[j] * r3 * g; }
        }
    }
}

extern "C" void kernel_launch(void* const* d_in, const int* in_sizes, int n_in, void* d_out, int out_size, void* d_ws, size_t ws_size, hipStream_t stream) {
    static int grid_blocks = 0;
    if (grid_blocks == 0) {
        if (n_in != 20 || ws_size < WS_END) { fprintf(stderr, "kernel_launch: unexpected n_in %d / ws_size %zu (need %zu)\n", n_in, ws_size, (size_t)WS_END); grid_blocks = -1; return; }
        int dev = 0, cus = 0, per_cu = 0;
        (void)hipGetDevice(&dev);
        (void)hipDeviceGetAttribute(&cus, hipDeviceAttributeMultiprocessorCount, dev);
        (void)hipFuncSetAttribute((const void*)fwd_megakernel, hipFuncAttributeMaxDynamicSharedMemorySize, LDS_BYTES);
        (void)hipOccupancyMaxActiveBlocksPerMultiprocessor(&per_cu, (const void*)fwd_megakernel, 512, LDS_BYTES);
        if (per_cu < 1) { fprintf(stderr, "kernel_launch: occupancy query reports %d blocks per CU\n", per_cu); per_cu = 1; }
        if (per_cu > 1) per_cu = 1;
        grid_blocks = cus * per_cu;
    }
    if (grid_blocks < 0) return;
    if (hipMemsetAsync((char*)d_ws + WS_BAR, 0, 16384, stream) != hipSuccess) { fprintf(stderr, "kernel_launch: hipMemsetAsync failed\n"); return; }
    KArgs a{};
    for (int i = 0; i < 20; ++i) a.in[i] = (const float*)d_in[i];
    a.out = (float*)d_out; a.ws = (unsigned char*)d_ws;
    void* kargs[] = {&a};
    hipError_t e = hipLaunchCooperativeKernel((const void*)fwd_megakernel, dim3(grid_blocks), dim3(512), kargs, LDS_BYTES, stream);
    if (e != hipSuccess) fprintf(stderr, "cooperative launch failed: %s (grid %d)\n", hipGetErrorString(e), grid_blocks);
}
```
